# Optimizing an MI355X kernel written in HIP

```python
import jax, jax.numpy as jnp
from jax import lax
import numpy as np

D_MODEL = 2048
BATCH = 4
SEQ = 8192
DEPTH = 1

D_RNN = 2048
N_RNN_BLOCKS = 8
RNN_BLOCK = D_RNN // N_RNN_BLOCKS
CONV_WIDTH = 4
LRU_C = 8.0
N_Q_HEADS = 32
N_KV_HEADS = 4
HEAD_DIM = 64
Q_GROUP = N_Q_HEADS // N_KV_HEADS
WINDOW = 128
ATTN_BLOCK = 128
ROPE_THETA = 10000.0
D_FF = 4 * D_MODEL
RMS_EPS = 1e-6
NEG_INF = -1e30

IN_SPLITS = (D_RNN, D_RNN, N_Q_HEADS * HEAD_DIM, N_KV_HEADS * HEAD_DIM, N_KV_HEADS * HEAD_DIM, D_MODEL, D_MODEL)
IN_OFFSETS = tuple(int(o) for o in np.cumsum(IN_SPLITS)[:-1])
D_IN = int(sum(IN_SPLITS))

kernel_name = "hybrid_rglru_swa_sink_gated_block"


def rmsnorm(x, g):
    xf = x.astype(jnp.float32)
    y = xf * lax.rsqrt(jnp.mean(xf * xf, axis=-1, keepdims=True) + RMS_EPS)
    return (y * g.astype(jnp.float32)).astype(x.dtype)


def rope(x, positions):
    half = HEAD_DIM // 2
    inv_freq = ROPE_THETA ** (-jnp.arange(0, HEAD_DIM, 2, dtype=jnp.float32) / HEAD_DIM)
    ang = positions.astype(jnp.float32)[..., None] * inv_freq
    cos = jnp.cos(ang)[:, :, None, :]
    sin = jnp.sin(ang)[:, :, None, :]
    xf = x.astype(jnp.float32)
    x1, x2 = xf[..., :half], xf[..., half:]
    out = jnp.concatenate([x1 * cos - x2 * sin, x2 * cos + x1 * sin], axis=-1)
    return out.astype(x.dtype)


def causal_depthwise_conv(x, w, b):
    S = x.shape[1]
    xp = jnp.pad(x, ((0, 0), (CONV_WIDTH - 1, 0), (0, 0)))
    y = b
    for k in range(CONV_WIDTH):
        y = y + xp[:, k:k + S] * w[k]
    return y


def rg_lru(x, positions, w_a, b_a, w_x, b_x, lam):
    B, S, _ = x.shape
    xf = x.astype(jnp.float32)
    xb = xf.reshape(B, S, N_RNN_BLOCKS, RNN_BLOCK)
    r = jax.nn.sigmoid(jnp.einsum('bsni,nij->bsnj', xb, w_a.astype(jnp.float32)).reshape(B, S, D_RNN) + b_a)
    i = jax.nn.sigmoid(jnp.einsum('bsni,nij->bsnj', xb, w_x.astype(jnp.float32)).reshape(B, S, D_RNN) + b_x)
    log_a = -LRU_C * r * jax.nn.softplus(-lam.astype(jnp.float32))
    a = jnp.exp(log_a)
    mult = jnp.sqrt(-jnp.expm1(2.0 * log_a))
    reset = (positions == 0)[..., None]
    a = jnp.where(reset, 0.0, a)
    mult = jnp.where(reset, 1.0, mult)
    b = mult * (i * xf)

    def combine(left, right):
        a_l, b_l = left
        a_r, b_r = right
        return a_l * a_r, a_r * b_l + b_r

    _, h = lax.associative_scan(combine, (a, b), axis=1)
    return h.astype(x.dtype)


def sliding_window_sink_attention(q, k, v, sinks):
    B, S = q.shape[0], q.shape[1]
    T = ATTN_BLOCK
    NB = S // T
    scale = HEAD_DIM ** -0.5
    qb = q.reshape(B, NB, T, N_KV_HEADS, Q_GROUP, HEAD_DIM) * scale
    kb = k.reshape(B, NB, T, N_KV_HEADS, HEAD_DIM)
    vb = v.reshape(B, NB, T, N_KV_HEADS, HEAD_DIM)
    pad = ((0, 0), (1, 0), (0, 0), (0, 0), (0, 0))
    kk = jnp.concatenate([jnp.pad(kb, pad)[:, :-1], kb], axis=2)
    vv = jnp.concatenate([jnp.pad(vb, pad)[:, :-1], vb], axis=2)
    scores = jnp.einsum('bnqhgd,bnkhd->bnhgqk', qb, kk).astype(jnp.float32)
    qi = jnp.arange(T)[:, None]
    ki = jnp.arange(2 * T)[None, :]
    dist = qi + T - ki
    band = (dist >= 0) & (dist < WINDOW)
    not_pad = (jnp.arange(NB)[:, None, None] > 0) | (ki >= T)[None]
    valid = (band[None] & not_pad)[None, :, None, None]
    scores = jnp.where(valid, scores, NEG_INF)
    sink = sinks.astype(jnp.float32).reshape(N_KV_HEADS, Q_GROUP)[None, None, :, :, None, None]
    m = jnp.maximum(jnp.max(scores, axis=-1, keepdims=True), sink)
    p = jnp.exp(scores - m)
    denom = jnp.sum(p, axis=-1, keepdims=True) + jnp.exp(sink - m)
    probs = (p / denom).astype(v.dtype)
    out = jnp.einsum('bnhgqk,bnkhd->bnqhgd', probs, vv)
    return out.reshape(B, S, N_Q_HEADS * HEAD_DIM)


def setup_inputs(seed: int = 0) -> dict:
    key = jax.random.key(seed)
    ks = jax.random.split(key, 20)
    f32 = jnp.float32
    L = DEPTH

    def nrm(k, shape, scale):
        return jax.random.normal(k, shape, f32) * scale

    def gain(k):
        return 1.0 + 0.05 * jax.random.normal(k, (L, D_MODEL), f32)

    x = jax.random.normal(ks[0], (BATCH, SEQ, D_MODEL), f32)
    positions = jnp.broadcast_to(jnp.arange(SEQ, dtype=jnp.int32)[None, :], (BATCH, SEQ))
    u = jax.random.uniform(ks[9], (L, D_RNN), f32, 0.9, 0.999)
    a0 = u ** (1.0 / LRU_C)
    lru_lambda = jnp.log(a0) - jnp.log1p(-a0)
    return {
        "x": x,
        "positions": positions,
        "norm_mix_pre": gain(ks[1]),
        "w_in": nrm(ks[2], (L, D_MODEL, D_IN), D_MODEL ** -0.5),
        "conv_w": nrm(ks[3], (L, CONV_WIDTH, D_RNN), CONV_WIDTH ** -0.5),
        "conv_b": nrm(ks[4], (L, D_RNN), 0.01),
        "w_rg_a": nrm(ks[5], (L, N_RNN_BLOCKS, RNN_BLOCK, RNN_BLOCK), RNN_BLOCK ** -0.5),
        "b_rg_a": nrm(ks[6], (L, D_RNN), 0.01),
        "w_rg_x": nrm(ks[7], (L, N_RNN_BLOCKS, RNN_BLOCK, RNN_BLOCK), RNN_BLOCK ** -0.5),
        "b_rg_x": nrm(ks[8], (L, D_RNN), 0.01),
        "lru_lambda": lru_lambda,
        "attn_sinks": nrm(ks[10], (L, N_Q_HEADS), 0.5),
        "w_rnn_proj": nrm(ks[11], (L, D_RNN, D_MODEL), D_RNN ** -0.5),
        "w_attn_proj": nrm(ks[12], (L, N_Q_HEADS * HEAD_DIM, D_MODEL), (N_Q_HEADS * HEAD_DIM) ** -0.5),
        "w_out": nrm(ks[13], (L, D_MODEL, D_MODEL), D_MODEL ** -0.5),
        "norm_mix_post": gain(ks[14]),
        "norm_mlp_pre": gain(ks[15]),
        "w_mlp_up": nrm(ks[16], (L, D_MODEL, D_FF), D_MODEL ** -0.5),
        "w_mlp_down": nrm(ks[17], (L, D_FF, D_MODEL), D_FF ** -0.5),
        "norm_mlp_post": gain(ks[18]),
    }


def reference(x, positions, norm_mix_pre, w_in, conv_w, conv_b, w_rg_a, b_rg_a, w_rg_x, b_rg_x, lru_lambda, attn_sinks, w_rnn_proj, w_attn_proj, w_out, norm_mix_post, norm_mlp_pre, w_mlp_up, w_mlp_down, norm_mlp_post):
    B, S, _ = x.shape
    for l in range(DEPTH):
        h = rmsnorm(x, norm_mix_pre[l])
        proj = h @ w_in[l]
        xr, yr, q, k, v, g_rnn, g_attn = jnp.split(proj, IN_OFFSETS, axis=-1)
        xr = causal_depthwise_conv(xr, conv_w[l], conv_b[l])
        xr = rg_lru(xr, positions, w_rg_a[l], b_rg_a[l], w_rg_x[l], b_rg_x[l], lru_lambda[l])
        y_rnn = xr * jax.nn.gelu(yr)
        q = rope(q.reshape(B, S, N_Q_HEADS, HEAD_DIM), positions)
        k = rope(k.reshape(B, S, N_KV_HEADS, HEAD_DIM), positions)
        v = v.reshape(B, S, N_KV_HEADS, HEAD_DIM)
        y_att = sliding_window_sink_attention(q, k, v, attn_sinks[l])
        mix = jax.nn.sigmoid(g_rnn) * (y_rnn @ w_rnn_proj[l]) + jax.nn.sigmoid(g_attn) * (y_att @ w_attn_proj[l])
        x = x + rmsnorm(mix @ w_out[l], norm_mix_post[l])
        h = rmsnorm(x, norm_mlp_pre[l])
        u = jnp.square(jax.nn.relu(h @ w_mlp_up[l]))
        x = x + rmsnorm(u @ w_mlp_down[l], norm_mlp_post[l])
    return x
```

```cpp
#include <hip/hip_runtime.h>
#include <hip/hip_cooperative_groups.h>
#include <cstdio>
#include <cstdint>
namespace cg = cooperative_groups;

#define LAS __attribute__((address_space(3)))
typedef unsigned short bf16_t;
typedef short bf16x8 __attribute__((ext_vector_type(8)));
typedef short s16x4 __attribute__((ext_vector_type(4)));
typedef float f32x4 __attribute__((ext_vector_type(4)));
typedef float f32x2 __attribute__((ext_vector_type(2)));
typedef float f32x16 __attribute__((ext_vector_type(16)));
typedef unsigned u32x4 __attribute__((ext_vector_type(4)));
typedef unsigned u32x2 __attribute__((ext_vector_type(2)));

constexpr int D_MODEL = 2048, BATCH = 4, SEQ = 8192, M_TOK = BATCH * SEQ;
constexpr int D_RNN = 2048, D_FF = 8192, D_IN = 10752;
constexpr int OFF_XR = 0, OFF_YR = 2048, OFF_Q = 4096, OFF_K = 6144, OFF_V = 6400, OFF_GR = 6656, OFF_GA = 8704;
constexpr float RMS_EPS = 1e-6f;
constexpr float LOG2E = 1.4426950408889634f;

constexpr size_t MiB = 1u << 20;
constexpr size_t WS_COS = 0, WS_SIN = 4 * MiB, WS_SUMA = 8 * MiB, WS_SUMB = 10 * MiB, WS_HIN = 12 * MiB;
constexpr size_t WS_WRGA = 14 * MiB, WS_WRGX = 15 * MiB, WS_WIN = 16 * MiB, WS_WRNN = 58 * MiB, WS_WATT = 66 * MiB, WS_WOUT = 74 * MiB;
constexpr size_t WS_WUP = 82 * MiB, WS_WDN = 114 * MiB, WS_P = 146 * MiB, WS_H = 818 * MiB, WS_U = 146 * MiB, WS_D = 658 * MiB, WS_CTL = 946 * MiB, WS_END = 947 * MiB;

constexpr int LDS_BYTES = 147456;

typedef __bf16 bf16x2_t __attribute__((ext_vector_type(2)));
__device__ __forceinline__ unsigned cvt_pk_bf16(float lo, float hi) { const f32x2 v = {lo, hi}; const bf16x2_t b = __builtin_convertvector(v, bf16x2_t); return __builtin_bit_cast(unsigned, b); }
__device__ __forceinline__ float bf2f(unsigned short b) { return __uint_as_float(((unsigned)b) << 16); }
__device__ __forceinline__ float bflo(unsigned w) { return __uint_as_float(w << 16); }
__device__ __forceinline__ float bfhi(unsigned w) { return __uint_as_float(w & 0xffff0000u); }
__device__ __forceinline__ float sigmoidf_(float v) { return __builtin_amdgcn_rcpf(1.0f + __builtin_amdgcn_exp2f(-v * LOG2E)); }
__device__ __forceinline__ float gelu_tanh(float v) { const float u = 1.5957691216057308f * (v + 0.044715f * v * v * v); return v * sigmoidf_(u); }
__device__ __forceinline__ float wave_sum(float v) {
#pragma unroll
    for (int o = 1; o < 64; o <<= 1) v += __shfl_xor(v, o);
    return v;
}

namespace pg8 {
constexpr int BM = 256, BK = 64, HALF = 128, HTB = HALF * BK * 2, STAGE_BYTES = 8 * HTB, NXCD = 8, WGM = 8;
__host__ __device__ __forceinline__ int lds_byte(int r, int c) { const int st = (r >> 4) * 2 + (c >> 5), rr = r & 15, cc = c & 31, ob = rr * 64 + cc * 2; return st * 1024 + (ob ^ (((ob >> 9) & 1) << 5)); }
__host__ __device__ __forceinline__ void stage_rc(int b, int& R, int& C) { const int st = b / 1024, sb = b % 1024, swz = sb ^ (((sb >> 9) & 1) << 5); R = (st >> 1) * 16 + swz / 64; C = (st & 1) * 32 + (swz % 64) / 2; }
__host__ __device__ __forceinline__ int perm32(int rho) { const int n = rho >> 4, i = rho & 15; return 8 * (i >> 2) + 4 * n + (i & 3); }

struct Unit { int pm, pn; };
struct Gemm { const bf16_t* A; const bf16_t* Bt; int M, N, K, lda; };

struct StaticOrder {
    int nM, nN, nwg, G, c;
    __device__ void init(int M, int N, int G_, int c_) { nM = M / BM; nN = N / BM; nwg = nM * nN; G = G_; c = c_; }
    __device__ bool next(int i, Unit& u) const {
        const long L = (long)i * G + c; if (L >= nwg) return false;
        int wgid = (int)L; { const int q = nwg / NXCD, r = nwg % NXCD, xcd = wgid % NXCD, off = wgid / NXCD; wgid = (xcd < r ? xcd * (q + 1) : r * (q + 1) + (xcd - r) * q) + off; }
        const int nig = WGM * nN, gid = wgid / nig, fm = gid * WGM, gsz = (nM - fm) < WGM ? (nM - fm) : WGM;
        u.pm = fm + ((wgid % nig) % gsz); u.pn = (wgid % nig) / gsz; return true;
    }
};

struct EpiBf16 {
    static constexpr bool PERM = true;
    bf16_t* O; int ldc; int mode;
    template <int ACT> __device__ __forceinline__ void run(const f32x4 (&acc)[2][2][4][2], const Unit& u, int wr, int wc, int fr, int fq) const {
        const int row0 = u.pm * BM + wr * 64 + fr, col0 = u.pn * BM + wc * 32 + 8 * fq;
#pragma unroll
        for (int ai = 0; ai < 2; ++ai)
#pragma unroll
            for (int m = 0; m < 4; ++m) { bf16_t* rowp = O + (size_t)(row0 + ai * HALF + m * 16) * ldc + col0;
#pragma unroll
                for (int bj = 0; bj < 2; ++bj) { f32x4 v0 = acc[ai][bj][m][0], v1 = acc[ai][bj][m][1];
#pragma unroll
                    for (int e = 0; e < 4; ++e) {
                        if (ACT == 1) { v0[e] = gelu_tanh(v0[e]); v1[e] = gelu_tanh(v1[e]); }
                        if (ACT == 2) { v0[e] = sigmoidf_(v0[e]); v1[e] = sigmoidf_(v1[e]); }
                        if (ACT == 3) { const float a0 = fmaxf(v0[e], 0.f), a1 = fmaxf(v1[e], 0.f); v0[e] = a0 * a0; v1[e] = a1 * a1; }
                    }
                    u32x4 w; w.x = cvt_pk_bf16(v0[0], v0[1]); w.y = cvt_pk_bf16(v0[2], v0[3]); w.z = cvt_pk_bf16(v1[0], v1[1]); w.w = cvt_pk_bf16(v1[2], v1[3]);
                    *(u32x4*)(rowp + bj * HALF) = w; } }
    }
    __device__ __forceinline__ void operator()(const f32x4 (&acc)[2][2][4][2], const Unit& u, int wr, int wc, int fr, int fq) const {
        if (mode == 3) { run<3>(acc, u, wr, wc, fr, fq); return; }
        const int seg = u.pn;
        if (seg >= 8 && seg < 16) run<1>(acc, u, wr, wc, fr, fq);
        else if (seg >= 26) run<2>(acc, u, wr, wc, fr, fq);
        else run<0>(acc, u, wr, wc, fr, fq);
    }
};
struct EpiGate {
    static constexpr bool PERM = true;
    bf16_t* G; const bf16_t* P; int ld;
    __device__ __forceinline__ void operator()(const f32x4 (&acc)[2][2][4][2], const Unit& u, int wr, int wc, int fr, int fq) const {
        const int row0 = u.pm * BM + wr * 64 + fr, col0 = u.pn * BM + wc * 32 + 8 * fq;
#pragma unroll
        for (int ai = 0; ai < 2; ++ai)
#pragma unroll
            for (int m = 0; m < 4; ++m) { const size_t ro = (size_t)(row0 + ai * HALF + m * 16) * ld + col0;
#pragma unroll
                for (int bj = 0; bj < 2; ++bj) { const f32x4 v0 = acc[ai][bj][m][0], v1 = acc[ai][bj][m][1];
                    const u32x4 g = *(const u32x4*)(G + ro + bj * HALF);
                    float o[8];
                    o[0] = bflo(g.x) * v0[0]; o[1] = bfhi(g.x) * v0[1]; o[2] = bflo(g.y) * v0[2]; o[3] = bfhi(g.y) * v0[3];
                    o[4] = bflo(g.z) * v1[0]; o[5] = bfhi(g.z) * v1[1]; o[6] = bflo(g.w) * v1[2]; o[7] = bfhi(g.w) * v1[3];
                    if (P) { const u32x4 p = *(const u32x4*)(P + ro + bj * HALF);
                        o[0] += bflo(p.x); o[1] += bfhi(p.x); o[2] += bflo(p.y); o[3] += bfhi(p.y); o[4] += bflo(p.z); o[5] += bfhi(p.z); o[6] += bflo(p.w); o[7] += bfhi(p.w); }
                    u32x4 w; w.x = cvt_pk_bf16(o[0], o[1]); w.y = cvt_pk_bf16(o[2], o[3]); w.z = cvt_pk_bf16(o[4], o[5]); w.w = cvt_pk_bf16(o[6], o[7]);
                    *(u32x4*)(G + ro + bj * HALF) = w; } }
    }
};
struct EpiF32 {
    static constexpr bool PERM = false;
    float* O; int ldc;
    __device__ __forceinline__ void operator()(const f32x4 (&acc)[2][2][4][2], const Unit& u, int wr, int wc, int fr, int fq) const {
        const int row0 = u.pm * BM + wr * 64 + fr, col0 = u.pn * BM + wc * 32 + 4 * fq;
#pragma unroll
        for (int ai = 0; ai < 2; ++ai)
#pragma unroll
            for (int m = 0; m < 4; ++m) { float* rowp = O + (size_t)(row0 + ai * HALF + m * 16) * ldc + col0;
#pragma unroll
                for (int bj = 0; bj < 2; ++bj)
#pragma unroll
                    for (int n = 0; n < 2; ++n) *(f32x4*)(rowp + bj * HALF + n * 16) = acc[ai][bj][m][n]; }
    }
};

template <class Epi>
__device__ __forceinline__ void gemm_phase(LAS unsigned char* lds, const Gemm g, const StaticOrder& S, const Epi& E) {
    const int tid = threadIdx.x, wid = __builtin_amdgcn_readfirstlane(tid >> 6), lane = tid & 63, wr = wid >> 2, wc = wid & 3, fr = lane & 15, fq = lane >> 4;
    const int K = g.K, nt = K / BK, lda = g.lda;
    unsigned voffA[2], voffB[2];
#pragma unroll
    for (int i = 0; i < 2; ++i) { int R, C; stage_rc(tid * 16 + i * 8192, R, C); const int Rb = Epi::PERM ? ((R & ~31) + perm32(R & 31)) : R;
        voffA[i] = (unsigned)(R * lda + C) * 2u; voffB[i] = (unsigned)(Rb * K + C) * 2u; }
    const size_t kstep = (size_t)(BK * 2);
    const size_t hstepA = (size_t)HALF * lda * 2, hstepB = (size_t)HALF * K * 2;
    const size_t tstepA = 2 * hstepA, tstepB = 2 * hstepB;
    const unsigned ldsw = (unsigned)wid * 1024u;
    const int aoff = lds_byte(wr * 64 + fr, fq * 8), boff = lds_byte(wc * 32 + fr, fq * 8);
#define PG8_SA(b, h) (((b) * 2 + (h)) * HTB)
#define PG8_SB(b, h) ((4 + (b) * 2 + (h)) * HTB)
#define PG8_STAGE(bufoff, gbase, voff) do { _Pragma("unroll") for (int _i = 0; _i < 2; ++_i) \
        __builtin_amdgcn_global_load_lds((const unsigned*)((const char*)(gbase) + (voff)[_i]), (LAS unsigned*)(lds + (bufoff) + ldsw + _i * 8192), 16, 0, 0); } while (0)
#define PG8_LDA(dst, b, h) do { _Pragma("unroll") for (int m = 0; m < 4; ++m) _Pragma("unroll") for (int k = 0; k < 2; ++k) dst[m][k] = *(const LAS bf16x8*)(lds + PG8_SA(b, h) + aoff + m * 2048 + k * 1024); } while (0)
#define PG8_LDB(dst, b, h) do { _Pragma("unroll") for (int n = 0; n < 2; ++n) _Pragma("unroll") for (int k = 0; k < 2; ++k) dst[n][k] = *(const LAS bf16x8*)(lds + PG8_SB(b, h) + boff + n * 2048 + k * 1024); } while (0)
#define PG8_MMA(ai, bj, At, Bt) do { __builtin_amdgcn_s_setprio(1); _Pragma("unroll") for (int m = 0; m < 4; ++m) _Pragma("unroll") for (int n = 0; n < 2; ++n) _Pragma("unroll") for (int k = 0; k < 2; ++k) \
        acc[ai][bj][m][n] = __builtin_amdgcn_mfma_f32_16x16x32_bf16(Bt[n][k], At[m][k], acc[ai][bj][m][n], 0, 0, 0); __builtin_amdgcn_s_setprio(0); } while (0)
#define PG8_WAIT_V(n) asm volatile("s_waitcnt vmcnt(" #n ")" ::: "memory")
#define PG8_WAIT_L(n) asm volatile("s_waitcnt lgkmcnt(" #n ")" ::: "memory")
#define PG8_BAR __builtin_amdgcn_s_barrier()
#define PG8_SCHED __builtin_amdgcn_sched_barrier(0)
    Unit cur, nxt; int ui = 0;
    if (!S.next(0, cur)) return;
    f32x4 acc[2][2][4][2];
#pragma unroll
    for (int a = 0; a < 2; ++a)
#pragma unroll
        for (int b = 0; b < 2; ++b)
#pragma unroll
            for (int m = 0; m < 4; ++m)
#pragma unroll
                for (int n = 0; n < 2; ++n) acc[a][b][m][n] = (f32x4){0.f, 0.f, 0.f, 0.f};
    bf16x8 At[4][2], B0[2][2], B1[2][2];
    const char* cA = (const char*)g.A + (size_t)cur.pm * tstepA; const char* cB = (const char*)g.Bt + (size_t)cur.pn * tstepB;
    PG8_STAGE(PG8_SB(0, 0), cB, voffB); PG8_STAGE(PG8_SB(0, 1), cB + hstepB, voffB); PG8_STAGE(PG8_SA(0, 0), cA, voffA); PG8_STAGE(PG8_SA(0, 1), cA + hstepA, voffA);
    if (wr == 1) PG8_BAR;
    PG8_WAIT_V(2); PG8_BAR;
    PG8_STAGE(PG8_SB(1, 0), cB + kstep, voffB); PG8_STAGE(PG8_SA(1, 0), cA + kstep, voffA); PG8_STAGE(PG8_SB(1, 1), cB + hstepB + kstep, voffB);
    PG8_WAIT_V(6); PG8_BAR;
    for (;;) {
        const bool has_next = S.next(ui + 1, nxt);
        const char* nA = has_next ? (const char*)g.A + (size_t)nxt.pm * tstepA : cA; const char* nB = has_next ? (const char*)g.Bt + (size_t)nxt.pn * tstepB : cB;
        for (int t = 0; t < nt; t += 2) {
            const bool last = (t == nt - 2);
            const char* a1 = cA + (size_t)(t + 1) * kstep;
            const char* a2 = last ? nA : cA + (size_t)(t + 2) * kstep; const char* b2 = last ? nB : cB + (size_t)(t + 2) * kstep;
            const char* a3 = a2 + kstep; const char* b3 = b2 + kstep;
            PG8_LDB(B0, 0, 0); PG8_LDB(B1, 0, 1); PG8_SCHED; PG8_LDA(At, 0, 0); PG8_STAGE(PG8_SA(1, 1), a1 + hstepA, voffA);
            PG8_WAIT_V(8); PG8_WAIT_L(0); PG8_BAR; PG8_MMA(0, 0, At, B0); PG8_MMA(0, 1, At, B1); PG8_BAR; PG8_SCHED;
            PG8_LDA(At, 0, 1); PG8_STAGE(PG8_SB(0, 0), b2, voffB); PG8_STAGE(PG8_SB(0, 1), b2 + hstepB, voffB); PG8_STAGE(PG8_SA(0, 0), a2, voffA);
            PG8_WAIT_V(8); PG8_WAIT_L(0); PG8_BAR; PG8_MMA(1, 0, At, B0); PG8_MMA(1, 1, At, B1); PG8_BAR; PG8_SCHED;
            PG8_LDB(B0, 1, 0); PG8_LDB(B1, 1, 1); PG8_SCHED; PG8_LDA(At, 1, 0); PG8_STAGE(PG8_SA(0, 1), a2 + hstepA, voffA);
            PG8_WAIT_V(8); PG8_WAIT_L(0); PG8_BAR; PG8_MMA(0, 0, At, B0); PG8_MMA(0, 1, At, B1); PG8_BAR; PG8_SCHED;
            PG8_LDA(At, 1, 1); PG8_STAGE(PG8_SB(1, 0), b3, voffB); PG8_STAGE(PG8_SB(1, 1), b3 + hstepB, voffB); PG8_STAGE(PG8_SA(1, 0), a3, voffA);
            PG8_WAIT_V(8); PG8_WAIT_L(0); PG8_BAR; PG8_MMA(1, 0, At, B0); PG8_MMA(1, 1, At, B1); PG8_BAR; PG8_SCHED;
        }
        if (wr == 0) PG8_BAR;
        E(acc, cur, wr, wc, fr, fq);
        if (!has_next) break;
#pragma unroll
        for (int a = 0; a < 2; ++a)
#pragma unroll
            for (int b = 0; b < 2; ++b)
#pragma unroll
                for (int m = 0; m < 4; ++m)
#pragma unroll
                    for (int n = 0; n < 2; ++n) acc[a][b][m][n] = (f32x4){0.f, 0.f, 0.f, 0.f};
        cur = nxt; cA = nA; cB = nB; ++ui;
        if (wr == 1) PG8_BAR;
    }
    PG8_WAIT_V(0);
    PG8_BAR;
#undef PG8_SA
#undef PG8_SB
#undef PG8_STAGE
#undef PG8_LDA
#undef PG8_LDB
#undef PG8_MMA
#undef PG8_WAIT_V
#undef PG8_WAIT_L
#undef PG8_BAR
#undef PG8_SCHED
}
}

struct Args {
    const float* x; const int* pos; const float* g_pre; const float* w_in; const float* conv_w; const float* conv_b;
    const float* w_rg_a; const float* b_rg_a; const float* w_rg_x; const float* b_rg_x; const float* lam; const float* sinks;
    const float* w_rnn; const float* w_attn; const float* w_out; const float* g_post; const float* g_mlp_pre;
    const float* w_up; const float* w_down; const float* g_mlp_post;
    float* out; unsigned char* ws;
};

__device__ __forceinline__ void p0_transpose_item(const float* W, int K, int N, bf16_t* WT, LAS float* scr, int item, int lane) {
    const int nblk = N / 32, kb = item / nblk, nb = item % nblk, k0 = 64 * kb, n0 = 32 * nb;
#pragma unroll 8
    for (int i = 0; i < 32; ++i) { const int kk = 2 * i + (lane >> 5); scr[kk * 33 + (lane & 31)] = W[(size_t)(k0 + kk) * N + n0 + (lane & 31)]; }
    asm volatile("s_waitcnt lgkmcnt(0)" ::: "memory");
    const int c = lane & 7;
#pragma unroll
    for (int j = 0; j < 4; ++j) { const int n = (lane >> 3) + 8 * j; const LAS float* s = scr + (8 * c) * 33 + n;
        u32x4 o; o.x = cvt_pk_bf16(s[0 * 33], s[1 * 33]); o.y = cvt_pk_bf16(s[2 * 33], s[3 * 33]); o.z = cvt_pk_bf16(s[4 * 33], s[5 * 33]); o.w = cvt_pk_bf16(s[6 * 33], s[7 * 33]);
        *(u32x4*)(WT + (size_t)(n0 + n) * K + k0 + 8 * c) = o; }
    asm volatile("s_waitcnt lgkmcnt(0)" ::: "memory");
}

__device__ __forceinline__ void rms_row_to_bf16(const float* xrow, const float* g, bf16_t* orow, int lane) {
    const f32x4* xr = (const f32x4*)xrow + lane; const f32x4* gr = (const f32x4*)g + lane;
    f32x4 v[8]; float s = 0.f;
#pragma unroll
    for (int j = 0; j < 8; ++j) { v[j] = xr[64 * j]; s += (v[j].x * v[j].x + v[j].y * v[j].y) + (v[j].z * v[j].z + v[j].w * v[j].w); }
    const float rstd = 1.0f / sqrtf(wave_sum(s) * (1.f / D_MODEL) + RMS_EPS);
    u32x2* o8 = (u32x2*)orow + lane;
#pragma unroll
    for (int j = 0; j < 8; ++j) { const f32x4 gg = gr[64 * j]; u32x2 w; w.x = cvt_pk_bf16(v[j].x * rstd * gg.x, v[j].y * rstd * gg.y); w.y = cvt_pk_bf16(v[j].z * rstd * gg.z, v[j].w * rstd * gg.w); o8[64 * j] = w; }
}

constexpr int XC_LD = 264;
template <bool FINAL>
__device__ __forceinline__ void rnn_tile(const Args& a, LAS unsigned char* lds, int tile, int nblk) {
    const int tid = threadIdx.x, lane = tid & 63, w = __builtin_amdgcn_readfirstlane(tid >> 6), hi = lane >> 5, l32 = lane & 31;
    bf16_t* proj = (bf16_t*)(a.ws + WS_P);
    LAS bf16_t* xc = (LAS bf16_t*)lds;
    LAS unsigned* rmask = (LAS unsigned*)(lds + 128 * XC_LD * 2);
    const int tok0 = tile * 128, sidx0 = (tile & 63) * 128;
    {
        const int cgp = tid & 31, ts = tid >> 5, ch = nblk * 256 + cgp * 8;
        float wk[4][8], bb[8];
#pragma unroll
        for (int k = 0; k < 4; ++k) { const f32x4 w0 = *(const f32x4*)(a.conv_w + k * D_RNN + ch), w1 = *(const f32x4*)(a.conv_w + k * D_RNN + ch + 4);
            wk[k][0] = w0.x; wk[k][1] = w0.y; wk[k][2] = w0.z; wk[k][3] = w0.w; wk[k][4] = w1.x; wk[k][5] = w1.y; wk[k][6] = w1.z; wk[k][7] = w1.w; }
        { const f32x4 b0 = *(const f32x4*)(a.conv_b + ch), b1 = *(const f32x4*)(a.conv_b + ch + 4); bb[0] = b0.x; bb[1] = b0.y; bb[2] = b0.z; bb[3] = b0.w; bb[4] = b1.x; bb[5] = b1.y; bb[6] = b1.z; bb[7] = b1.w; }
        u32x4 raw[11];
#pragma unroll
        for (int j = 0; j < 11; ++j) { const int tl = ts * 8 + j - 3;
            if (sidx0 + tl >= 0) raw[j] = *(const u32x4*)(proj + (size_t)(tok0 + tl) * D_IN + OFF_XR + ch); else raw[j] = (u32x4){0u, 0u, 0u, 0u}; }
#pragma unroll
        for (int j = 0; j < 8; ++j) { float y[8];
#pragma unroll
            for (int e = 0; e < 8; ++e) y[e] = bb[e];
#pragma unroll
            for (int k = 0; k < 4; ++k) { const u32x4 r = raw[j + k];
                y[0] += wk[k][0] * bflo(r.x); y[1] += wk[k][1] * bfhi(r.x); y[2] += wk[k][2] * bflo(r.y); y[3] += wk[k][3] * bfhi(r.y);
                y[4] += wk[k][4] * bflo(r.z); y[5] += wk[k][5] * bfhi(r.z); y[6] += wk[k][6] * bflo(r.w); y[7] += wk[k][7] * bfhi(r.w); }
            u32x4 o; o.x = cvt_pk_bf16(y[0], y[1]); o.y = cvt_pk_bf16(y[2], y[3]); o.z = cvt_pk_bf16(y[4], y[5]); o.w = cvt_pk_bf16(y[6], y[7]);
            *(LAS u32x4*)(xc + (ts * 8 + j) * XC_LD + cgp * 8) = o; }
        if (tid < 128) { const bool z = (a.pos[tok0 + tid] == 0); const unsigned long long bal = __ballot(z); if (lane == 0) { rmask[2 * w] = (unsigned)bal; rmask[2 * w + 1] = (unsigned)(bal >> 32); } }
    }
    __syncthreads();
    const int cl = w * 32 + l32, c = nblk * 256 + cl;
    const bf16_t* wa = (const bf16_t*)(a.ws + WS_WRGA) + (size_t)nblk * 65536 + (size_t)cl * 256 + 8 * hi;
    const bf16_t* wx = (const bf16_t*)(a.ws + WS_WRGX) + (size_t)nblk * 65536 + (size_t)cl * 256 + 8 * hi;
    f32x16 ga[4], gx[4];
#pragma unroll
    for (int mb = 0; mb < 4; ++mb)
#pragma unroll
        for (int i = 0; i < 16; ++i) { ga[mb][i] = 0.f; gx[mb][i] = 0.f; }
    bf16x8 fa[4], fx[4];
#pragma unroll
    for (int p = 0; p < 3; ++p) { fa[p] = *(const bf16x8*)(wa + 16 * p); fx[p] = *(const bf16x8*)(wx + 16 * p); }
#pragma unroll
    for (int kk = 0; kk < 16; ++kk) {
        if (kk + 3 < 16) { fa[(kk + 3) & 3] = *(const bf16x8*)(wa + 16 * (kk + 3)); fx[(kk + 3) & 3] = *(const bf16x8*)(wx + 16 * (kk + 3)); }
#pragma unroll
        for (int mb = 0; mb < 4; ++mb) {
            const bf16x8 af = *(const LAS bf16x8*)(xc + (32 * mb + l32) * XC_LD + 16 * kk + 8 * hi);
            ga[mb] = __builtin_amdgcn_mfma_f32_32x32x16_bf16(af, fa[kk & 3], ga[mb], 0, 0, 0);
            gx[mb] = __builtin_amdgcn_mfma_f32_32x32x16_bf16(af, fx[kk & 3], gx[mb], 0, 0, 0);
        }
    }
    const float bav = a.b_rg_a[c], bxv = a.b_rg_x[c];
    const float nsp = -8.0f * LOG2E * log1pf(expf(-a.lam[c]));
    float H = 0.f, Atot = 1.f;
    if (FINAL) H = ((const float*)(a.ws + WS_HIN))[(size_t)tile * D_RNN + c];
    bf16_t* yrp = proj + (size_t)tok0 * D_IN + OFF_YR + c;
#pragma unroll
    for (int mb = 0; mb < 4; ++mb) {
        const unsigned mw = rmask[mb];
        float av[16], bv[16];
#pragma unroll
        for (int i = 0; i < 16; ++i) {
            const int row = 8 * (i >> 2) + 4 * hi + (i & 3);
            const float r = sigmoidf_(ga[mb][i] + bav), ig = sigmoidf_(gx[mb][i] + bxv);
            float aa = __builtin_amdgcn_exp2f(nsp * r);
            float mult = sqrtf(fmaxf(fmaf(-aa, aa, 1.0f), 0.f));
            if ((mw >> row) & 1u) { aa = 0.f; mult = 1.f; }
            const float xv = bf2f(xc[(32 * mb + row) * XC_LD + cl]);
            av[i] = aa; bv[i] = mult * ig * xv;
        }
#pragma unroll
        for (int g = 0; g < 4; ++g) {
            const float As = (av[4 * g] * av[4 * g + 1]) * (av[4 * g + 2] * av[4 * g + 3]);
            const float Bs = ((bv[4 * g] * av[4 * g + 1] + bv[4 * g + 1]) * av[4 * g + 2] + bv[4 * g + 2]) * av[4 * g + 3] + bv[4 * g + 3];
            const float Ao = __shfl_xor(As, 32), Bo = __shfl_xor(Bs, 32);
            const float Alo = hi ? Ao : As, Blo = hi ? Bo : Bs, Ahi = hi ? As : Ao, Bhi = hi ? Bs : Bo;
            if (FINAL) {
                float hs = hi ? (H * Alo + Blo) : H;
#pragma unroll
                for (int j = 0; j < 4; ++j) { hs = av[4 * g + j] * hs + bv[4 * g + j];
                    const int row = 32 * mb + 8 * g + 4 * hi + j; bf16_t* p = yrp + (size_t)row * D_IN;
                    const float y = hs * bf2f(*p); *p = (bf16_t)(cvt_pk_bf16(y, 0.f) & 0xffffu); }
            }
            H = (H * Alo + Blo) * Ahi + Bhi;
            if (!FINAL) Atot *= Alo * Ahi;
        }
    }
    if (!FINAL && hi == 0) { ((float*)(a.ws + WS_SUMA))[(size_t)tile * D_RNN + c] = Atot; ((float*)(a.ws + WS_SUMB))[(size_t)tile * D_RNN + c] = H; }
    __syncthreads();
}

constexpr int KS_LD = 72, VT_LD = 264, VT_OFF = 256 * KS_LD * 2;
__device__ __forceinline__ void attn_item(const Args& a, LAS unsigned char* lds, int item) {
    const int tid = threadIdx.x, lane = tid & 63, w = __builtin_amdgcn_readfirstlane(tid >> 6), hi = lane >> 5, l32 = lane & 31;
    const int b = item >> 8, nb = (item >> 2) & 63, hk = item & 3;
    bf16_t* proj = (bf16_t*)(a.ws + WS_P);
    const float* tcos = (const float*)(a.ws + WS_COS); const float* tsin = (const float*)(a.ws + WS_SIN);
    LAS bf16_t* Ks = (LAS bf16_t*)lds; LAS bf16_t* Vt = (LAS bf16_t*)(lds + VT_OFF);
    const int tok0 = b * SEQ + nb * 128;
    {
        const int key = tid >> 1, part = tid & 1;
        if (nb == 0 && key < 128) {
            const u32x4 z = (u32x4){0u, 0u, 0u, 0u};
            *(LAS u32x4*)(Ks + key * KS_LD + 16 * part) = z; *(LAS u32x4*)(Ks + key * KS_LD + 16 * part + 8) = z;
            *(LAS u32x4*)(Ks + key * KS_LD + 32 + 16 * part) = z; *(LAS u32x4*)(Ks + key * KS_LD + 32 + 16 * part + 8) = z;
#pragma unroll
            for (int e = 0; e < 32; ++e) Vt[(32 * part + e) * VT_LD + key] = 0;
        } else {
            const int tok = tok0 - 128 + key;
            const bf16_t* ksrc = proj + (size_t)tok * D_IN + OFF_K + hk * 64 + 16 * part;
            const u32x4 x1a = *(const u32x4*)(ksrc), x1b = *(const u32x4*)(ksrc + 8), x2a = *(const u32x4*)(ksrc + 32), x2b = *(const u32x4*)(ksrc + 40);
            float x1[16], x2[16], cs[16], sn[16];
            x1[0] = bflo(x1a.x); x1[1] = bfhi(x1a.x); x1[2] = bflo(x1a.y); x1[3] = bfhi(x1a.y); x1[4] = bflo(x1a.z); x1[5] = bfhi(x1a.z); x1[6] = bflo(x1a.w); x1[7] = bfhi(x1a.w);
            x1[8] = bflo(x1b.x); x1[9] = bfhi(x1b.x); x1[10] = bflo(x1b.y); x1[11] = bfhi(x1b.y); x1[12] = bflo(x1b.z); x1[13] = bfhi(x1b.z); x1[14] = bflo(x1b.w); x1[15] = bfhi(x1b.w);
            x2[0] = bflo(x2a.x); x2[1] = bfhi(x2a.x); x2[2] = bflo(x2a.y); x2[3] = bfhi(x2a.y); x2[4] = bflo(x2a.z); x2[5] = bfhi(x2a.z); x2[6] = bflo(x2a.w); x2[7] = bfhi(x2a.w);
            x2[8] = bflo(x2b.x); x2[9] = bfhi(x2b.x); x2[10] = bflo(x2b.y); x2[11] = bfhi(x2b.y); x2[12] = bflo(x2b.z); x2[13] = bfhi(x2b.z); x2[14] = bflo(x2b.w); x2[15] = bfhi(x2b.w);
#pragma unroll
            for (int q4 = 0; q4 < 4; ++q4) { const f32x4 cv = *(const f32x4*)(tcos + (size_t)tok * 32 + 16 * part + 4 * q4), sv = *(const f32x4*)(tsin + (size_t)tok * 32 + 16 * part + 4 * q4);
                cs[4 * q4] = cv.x; cs[4 * q4 + 1] = cv.y; cs[4 * q4 + 2] = cv.z; cs[4 * q4 + 3] = cv.w; sn[4 * q4] = sv.x; sn[4 * q4 + 1] = sv.y; sn[4 * q4 + 2] = sv.z; sn[4 * q4 + 3] = sv.w; }
            float o1[16], o2[16];
#pragma unroll
            for (int e = 0; e < 16; ++e) { o1[e] = x1[e] * cs[e] - x2[e] * sn[e]; o2[e] = x2[e] * cs[e] + x1[e] * sn[e]; }
            u32x4 wv;
            wv.x = cvt_pk_bf16(o1[0], o1[1]); wv.y = cvt_pk_bf16(o1[2], o1[3]); wv.z = cvt_pk_bf16(o1[4], o1[5]); wv.w = cvt_pk_bf16(o1[6], o1[7]); *(LAS u32x4*)(Ks + key * KS_LD + 16 * part) = wv;
            wv.x = cvt_pk_bf16(o1[8], o1[9]); wv.y = cvt_pk_bf16(o1[10], o1[11]); wv.z = cvt_pk_bf16(o1[12], o1[13]); wv.w = cvt_pk_bf16(o1[14], o1[15]); *(LAS u32x4*)(Ks + key * KS_LD + 16 * part + 8) = wv;
            wv.x = cvt_pk_bf16(o2[0], o2[1]); wv.y = cvt_pk_bf16(o2[2], o2[3]); wv.z = cvt_pk_bf16(o2[4], o2[5]); wv.w = cvt_pk_bf16(o2[6], o2[7]); *(LAS u32x4*)(Ks + key * KS_LD + 32 + 16 * part) = wv;
            wv.x = cvt_pk_bf16(o2[8], o2[9]); wv.y = cvt_pk_bf16(o2[10], o2[11]); wv.z = cvt_pk_bf16(o2[12], o2[13]); wv.w = cvt_pk_bf16(o2[14], o2[15]); *(LAS u32x4*)(Ks + key * KS_LD + 32 + 16 * part + 8) = wv;
            const bf16_t* vsrc = proj + (size_t)tok * D_IN + OFF_V + hk * 64 + 32 * part;
#pragma unroll
            for (int q4 = 0; q4 < 4; ++q4) { const u32x4 vv = *(const u32x4*)(vsrc + 8 * q4); LAS bf16_t* vd = Vt + (32 * part + 8 * q4) * VT_LD + key;
                vd[0 * VT_LD] = (bf16_t)(vv.x & 0xffffu); vd[1 * VT_LD] = (bf16_t)(vv.x >> 16); vd[2 * VT_LD] = (bf16_t)(vv.y & 0xffffu); vd[3 * VT_LD] = (bf16_t)(vv.y >> 16);
                vd[4 * VT_LD] = (bf16_t)(vv.z & 0xffffu); vd[5 * VT_LD] = (bf16_t)(vv.z >> 16); vd[6 * VT_LD] = (bf16_t)(vv.w & 0xffffu); vd[7 * VT_LD] = (bf16_t)(vv.w >> 16); }
        }
    }
    __syncthreads();
    const int hq = hk * 8 + w;
    const float sink2 = a.sinks[hq] * LOG2E;
    const float CS = 0.125f * LOG2E;
#pragma unroll 1
    for (int qq = 0; qq < 4; ++qq) {
        const int tokq = tok0 + 32 * qq + l32;
        bf16_t* qsrc = proj + (size_t)tokq * D_IN + OFF_Q + hq * 64;
        bf16x8 qf[4];
        {
            u32x4 raw[4];
#pragma unroll
            for (int dd = 0; dd < 4; ++dd) raw[dd] = *(const u32x4*)(qsrc + 16 * dd + 8 * hi);
#pragma unroll
            for (int d2 = 0; d2 < 2; ++d2) {
                const float* cp = tcos + (size_t)tokq * 32 + 16 * d2 + 8 * hi; const float* sp = tsin + (size_t)tokq * 32 + 16 * d2 + 8 * hi;
                const f32x4 c0 = *(const f32x4*)cp, c1 = *(const f32x4*)(cp + 4), s0 = *(const f32x4*)sp, s1 = *(const f32x4*)(sp + 4);
                const float cs[8] = {c0.x, c0.y, c0.z, c0.w, c1.x, c1.y, c1.z, c1.w}, sn[8] = {s0.x, s0.y, s0.z, s0.w, s1.x, s1.y, s1.z, s1.w};
                const u32x4 r1 = raw[d2], r2 = raw[d2 + 2];
                const float x1[8] = {bflo(r1.x), bfhi(r1.x), bflo(r1.y), bfhi(r1.y), bflo(r1.z), bfhi(r1.z), bflo(r1.w), bfhi(r1.w)};
                const float x2[8] = {bflo(r2.x), bfhi(r2.x), bflo(r2.y), bfhi(r2.y), bflo(r2.z), bfhi(r2.z), bflo(r2.w), bfhi(r2.w)};
                float o1[8], o2[8];
#pragma unroll
                for (int e = 0; e < 8; ++e) { o1[e] = x1[e] * cs[e] - x2[e] * sn[e]; o2[e] = x2[e] * cs[e] + x1[e] * sn[e]; }
                u32x4 w1, w2;
                w1.x = cvt_pk_bf16(o1[0], o1[1]); w1.y = cvt_pk_bf16(o1[2], o1[3]); w1.z = cvt_pk_bf16(o1[4], o1[5]); w1.w = cvt_pk_bf16(o1[6], o1[7]);
                w2.x = cvt_pk_bf16(o2[0], o2[1]); w2.y = cvt_pk_bf16(o2[2], o2[3]); w2.z = cvt_pk_bf16(o2[4], o2[5]); w2.w = cvt_pk_bf16(o2[6], o2[7]);
                qf[d2] = __builtin_bit_cast(bf16x8, w1); qf[d2 + 2] = __builtin_bit_cast(bf16x8, w2);
            }
        }
        f32x16 s[5];
#pragma unroll
        for (int kbi = 0; kbi < 5; ++kbi) {
#pragma unroll
            for (int i = 0; i < 16; ++i) s[kbi][i] = 0.f;
            const LAS bf16_t* kp = Ks + (32 * (qq + kbi) + l32) * KS_LD + 8 * hi;
#pragma unroll
            for (int dd = 0; dd < 4; ++dd) { const bf16x8 kf = *(const LAS bf16x8*)(kp + 16 * dd); s[kbi] = __builtin_amdgcn_mfma_f32_32x32x16_bf16(kf, qf[dd], s[kbi], 0, 0, 0); }
        }
        float mx = -1e30f;
#pragma unroll
        for (int kbi = 0; kbi < 5; ++kbi) {
            const bool blk_ok = !(nb == 0 && qq + kbi < 4);
#pragma unroll
            for (int i = 0; i < 16; ++i) { const int row = 8 * (i >> 2) + 4 * hi + (i & 3);
                bool ok = blk_ok; if (kbi == 0) ok = ok && (row > l32); if (kbi == 4) ok = ok && (row <= l32);
                const float v = ok ? s[kbi][i] * CS : -1e30f; s[kbi][i] = v; mx = fmaxf(mx, v); }
        }
        mx = fmaxf(mx, __shfl_xor(mx, 32)); mx = fmaxf(mx, sink2);
        float lsum = 0.f;
        bf16x8 pk[5][2];
#pragma unroll
        for (int kbi = 0; kbi < 5; ++kbi) {
#pragma unroll
            for (int i = 0; i < 16; ++i) { const float p = __builtin_amdgcn_exp2f(s[kbi][i] - mx); s[kbi][i] = p; lsum += p; }
#pragma unroll
            for (int j2 = 0; j2 < 2; ++j2) { u32x4 pw;
                pw.x = cvt_pk_bf16(s[kbi][8 * j2 + 0], s[kbi][8 * j2 + 1]); pw.y = cvt_pk_bf16(s[kbi][8 * j2 + 2], s[kbi][8 * j2 + 3]);
                pw.z = cvt_pk_bf16(s[kbi][8 * j2 + 4], s[kbi][8 * j2 + 5]); pw.w = cvt_pk_bf16(s[kbi][8 * j2 + 6], s[kbi][8 * j2 + 7]);
                pk[kbi][j2] = __builtin_bit_cast(bf16x8, pw); }
        }
        lsum += __shfl_xor(lsum, 32); lsum += __builtin_amdgcn_exp2f(sink2 - mx);
        const float inv = 1.0f / lsum;
        f32x16 o[2];
#pragma unroll
        for (int db = 0; db < 2; ++db)
#pragma unroll
            for (int i = 0; i < 16; ++i) o[db][i] = 0.f;
#pragma unroll
        for (int kbi = 0; kbi < 5; ++kbi)
#pragma unroll
            for (int j2 = 0; j2 < 2; ++j2)
#pragma unroll
                for (int db = 0; db < 2; ++db) {
                    const LAS bf16_t* vp = Vt + (32 * db + l32) * VT_LD + 32 * (qq + kbi) + 16 * j2 + 4 * hi;
                    const s16x4 lo = *(const LAS s16x4*)vp, hh = *(const LAS s16x4*)(vp + 8);
                    const bf16x8 vf = (bf16x8){lo[0], lo[1], lo[2], lo[3], hh[0], hh[1], hh[2], hh[3]};
                    o[db] = __builtin_amdgcn_mfma_f32_32x32x16_bf16(vf, pk[kbi][j2], o[db], 0, 0, 0);
                }
#pragma unroll
        for (int db = 0; db < 2; ++db)
#pragma unroll
            for (int g = 0; g < 4; ++g) { u32x2 wv; wv.x = cvt_pk_bf16(o[db][4 * g] * inv, o[db][4 * g + 1] * inv); wv.y = cvt_pk_bf16(o[db][4 * g + 2] * inv, o[db][4 * g + 3] * inv);
                *(u32x2*)(qsrc + 32 * db + 8 * g + 4 * hi) = wv; }
    }
    __syncthreads();
}

__device__ __forceinline__ void grid_barrier(unsigned* ctr, unsigned target) {
    asm volatile("s_waitcnt vmcnt(0) lgkmcnt(0)" ::: "memory");
    __syncthreads();
    if (threadIdx.x == 0) {
        __builtin_amdgcn_fence(__ATOMIC_RELEASE, "agent");
        asm volatile("s_waitcnt vmcnt(0)" ::: "memory");
        __hip_atomic_fetch_add(ctr, 1u, __ATOMIC_RELAXED, __HIP_MEMORY_SCOPE_AGENT);
        while (__hip_atomic_load(ctr, __ATOMIC_RELAXED, __HIP_MEMORY_SCOPE_AGENT) < target) __builtin_amdgcn_s_sleep(2);
        __builtin_amdgcn_fence(__ATOMIC_ACQUIRE, "agent");
        asm volatile("s_waitcnt vmcnt(0)" ::: "memory");
    }
    __syncthreads();
}
#define GRID_SYNC() do { ++bar_k; grid_barrier(bar_ctr, bar_k * (unsigned)gridDim.x); } while (0)
__global__ void __launch_bounds__(512, 2) fwd_megakernel(Args a) {
    extern __shared__ __attribute__((aligned(16))) unsigned char lds_raw[];
    LAS unsigned char* lds = (LAS unsigned char*)lds_raw;
    cg::grid_group grid = cg::this_grid();
    const int tid = threadIdx.x, lane = tid & 63, wave = __builtin_amdgcn_readfirstlane(tid >> 6);
    const int G = gridDim.x, bx = blockIdx.x;
    const int gw = bx * 8 + wave, NGW = G * 8;
    bf16_t* proj = (bf16_t*)(a.ws + WS_P);
    bf16_t* Hb = (bf16_t*)(a.ws + WS_H);
    unsigned* bar_ctr = (unsigned*)(a.ws + WS_CTL); unsigned bar_k = 0;
    grid.sync();

    {
        LAS float* scr = (LAS float*)(lds + wave * 16384);
        constexpr int I_IN = (D_MODEL / 64) * (D_IN / 32), I_SQ = (2048 / 64) * (2048 / 32), I_UP = (D_MODEL / 64) * (D_FF / 32), I_DN = (D_FF / 64) * (D_MODEL / 32), I_RG = 8 * 32;
        constexpr int NITEMS = I_IN + 3 * I_SQ + I_UP + I_DN + 2 * I_RG;
        for (int it = gw; it < NITEMS; it += NGW) {
            int r = it;
            if (r < I_IN) { p0_transpose_item(a.w_in, D_MODEL, D_IN, (bf16_t*)(a.ws + WS_WIN), scr, r, lane); continue; } r -= I_IN;
            if (r < I_SQ) { p0_transpose_item(a.w_rnn, 2048, 2048, (bf16_t*)(a.ws + WS_WRNN), scr, r, lane); continue; } r -= I_SQ;
            if (r < I_SQ) { p0_transpose_item(a.w_attn, 2048, 2048, (bf16_t*)(a.ws + WS_WATT), scr, r, lane); continue; } r -= I_SQ;
            if (r < I_SQ) { p0_transpose_item(a.w_out, 2048, 2048, (bf16_t*)(a.ws + WS_WOUT), scr, r, lane); continue; } r -= I_SQ;
            if (r < I_UP) { p0_transpose_item(a.w_up, D_MODEL, D_FF, (bf16_t*)(a.ws + WS_WUP), scr, r, lane); continue; } r -= I_UP;
            if (r < I_DN) { p0_transpose_item(a.w_down, D_FF, D_MODEL, (bf16_t*)(a.ws + WS_WDN), scr, r, lane); continue; } r -= I_DN;
            if (r < I_RG) { const int nb = r >> 5; p0_transpose_item(a.w_rg_a + (size_t)nb * 65536, 256, 256, (bf16_t*)(a.ws + WS_WRGA) + (size_t)nb * 65536, scr, r & 31, lane); continue; } r -= I_RG;
            { const int nb = r >> 5; p0_transpose_item(a.w_rg_x + (size_t)nb * 65536, 256, 256, (bf16_t*)(a.ws + WS_WRGX) + (size_t)nb * 65536, scr, r & 31, lane); }
        }
        for (int m = gw; m < M_TOK; m += NGW) rms_row_to_bf16(a.x + (size_t)m * D_MODEL, a.g_pre, Hb + (size_t)m * D_MODEL, lane);
        float* tcos = (float*)(a.ws + WS_COS); float* tsin = (float*)(a.ws + WS_SIN);
        for (int i = bx * 512 + tid; i < M_TOK * 32; i += G * 512) {
            const int tok = i >> 5, f = i & 31;
            const float inv_freq = exp2f(-(float)f * (13.287712379549449f / 32.0f));
            const float ang = (float)a.pos[tok] * inv_freq;
            float sv, cv; sincosf(ang, &sv, &cv); tcos[i] = cv; tsin[i] = sv;
        }
    }
    GRID_SYNC();
    {
        pg8::Gemm g{Hb, (const bf16_t*)(a.ws + WS_WIN), M_TOK, D_IN, D_MODEL, D_MODEL}; pg8::StaticOrder S; S.init(M_TOK, D_IN, G, bx);
        pg8::EpiBf16 E{proj, D_IN, 0};
        pg8::gemm_phase<pg8::EpiBf16>(lds, g, S, E);
    }
    GRID_SYNC();
    for (int it = bx; it < 256 * 8; it += G) rnn_tile<false>(a, lds, it >> 3, it & 7);
    GRID_SYNC();
    {
        if (tid < 32) {
            const int gi = bx * 32 + tid;
            if (gi < BATCH * D_RNN) {
                const int b = gi / D_RNN, ch = gi % D_RNN;
                const float* sa = (const float*)(a.ws + WS_SUMA) + (size_t)b * 64 * D_RNN + ch; const float* sb = (const float*)(a.ws + WS_SUMB) + (size_t)b * 64 * D_RNN + ch;
                float* hin = (float*)(a.ws + WS_HIN) + (size_t)b * 64 * D_RNN + ch;
                float H = 0.f;
                for (int j0 = 0; j0 < 64; j0 += 8) {
                    float av[8], bv[8];
#pragma unroll
                    for (int j = 0; j < 8; ++j) { av[j] = sa[(size_t)(j0 + j) * D_RNN]; bv[j] = sb[(size_t)(j0 + j) * D_RNN]; }
#pragma unroll
                    for (int j = 0; j < 8; ++j) { hin[(size_t)(j0 + j) * D_RNN] = H; H = H * av[j] + bv[j]; }
                }
            }
        }
        for (int it = bx; it < 1024; it += G) attn_item(a, lds, it);
    }
    GRID_SYNC();
    for (int it = bx; it < 256 * 8; it += G) rnn_tile<true>(a, lds, it >> 3, it & 7);
    GRID_SYNC();
    {
        pg8::StaticOrder S; S.init(M_TOK, D_MODEL, G, bx);
        { pg8::Gemm g{proj + OFF_YR, (const bf16_t*)(a.ws + WS_WRNN), M_TOK, D_MODEL, D_RNN, D_IN};
          pg8::EpiGate E{proj + OFF_GR, nullptr, D_IN}; pg8::gemm_phase<pg8::EpiGate>(lds, g, S, E); }
        { pg8::Gemm g{proj + OFF_Q, (const bf16_t*)(a.ws + WS_WATT), M_TOK, D_MODEL, 2048, D_IN};
          pg8::EpiGate E{proj + OFF_GA, proj + OFF_GR, D_IN}; pg8::gemm_phase<pg8::EpiGate>(lds, g, S, E); }
    }
    GRID_SYNC();
    {
        pg8::Gemm g{proj + OFF_GA, (const bf16_t*)(a.ws + WS_WOUT), M_TOK, D_MODEL, D_MODEL, D_IN}; pg8::StaticOrder S; S.init(M_TOK, D_MODEL, G, bx);
        pg8::EpiF32 E{a.out, D_MODEL}; pg8::gemm_phase<pg8::EpiF32>(lds, g, S, E);
    }
    GRID_SYNC();
    for (int m = gw; m < M_TOK; m += NGW) {
        f32x4* tr = (f32x4*)(a.out + (size_t)m * D_MODEL) + lane; const f32x4* xr = (const f32x4*)(a.x + (size_t)m * D_MODEL) + lane;
        const f32x4* g1 = (const f32x4*)a.g_post + lane; const f32x4* g2 = (const f32x4*)a.g_mlp_pre + lane;
        f32x4 v[8]; float s = 0.f;
#pragma unroll
        for (int j = 0; j < 8; ++j) { v[j] = tr[64 * j]; s += (v[j].x * v[j].x + v[j].y * v[j].y) + (v[j].z * v[j].z + v[j].w * v[j].w); }
        const float rstd = 1.0f / sqrtf(wave_sum(s) * (1.f / D_MODEL) + RMS_EPS);
        float s2 = 0.f;
#pragma unroll
        for (int j = 0; j < 8; ++j) { const f32x4 xx = xr[64 * j], gg = g1[64 * j]; v[j] = xx + v[j] * rstd * gg; tr[64 * j] = v[j]; s2 += (v[j].x * v[j].x + v[j].y * v[j].y) + (v[j].z * v[j].z + v[j].w * v[j].w); }
        const float rstd2 = 1.0f / sqrtf(wave_sum(s2) * (1.f / D_MODEL) + RMS_EPS);
        u32x2* o8 = (u32x2*)(Hb + (size_t)m * D_MODEL) + lane;
#pragma unroll
        for (int j = 0; j < 8; ++j) { const f32x4 gg = g2[64 * j]; u32x2 w; w.x = cvt_pk_bf16(v[j].x * rstd2 * gg.x, v[j].y * rstd2 * gg.y); w.y = cvt_pk_bf16(v[j].z * rstd2 * gg.z, v[j].w * rstd2 * gg.w); o8[64 * j] = w; }
    }
    GRID_SYNC();
    {
        pg8::Gemm g{Hb, (const bf16_t*)(a.ws + WS_WUP), M_TOK, D_FF, D_MODEL, D_MODEL}; pg8::StaticOrder S; S.init(M_TOK, D_FF, G, bx);
        pg8::EpiBf16 E{(bf16_t*)(a.ws + WS_U), D_FF, 3}; pg8::gemm_phase<pg8::EpiBf16>(lds, g, S, E);
    }
    GRID_SYNC();
    {
        pg8::Gemm g{(const bf16_t*)(a.ws + WS_U), (const bf16_t*)(a.ws + WS_WDN), M_TOK, D_MODEL, D_FF, D_FF}; pg8::StaticOrder S; S.init(M_TOK, D_MODEL, G, bx);
        pg8::EpiF32 E{(float*)(a.ws + WS_D), D_MODEL}; pg8::gemm_phase<pg8::EpiF32>(lds, g, S, E);
    }
    GRID_SYNC();
    for (int m = gw; m < M_TOK; m += NGW) {
        f32x4* orow = (f32x4*)(a.out + (size_t)m * D_MODEL) + lane; const f32x4* dr = (const f32x4*)((const float*)(a.ws + WS_D) + (size_t)m * D_MODEL) + lane;
        const f32x4* g1 = (const f32x4*)a.g_mlp_post + lane;
        f32x4 v[8]; float s = 0.f;
#pragma unroll
        for (int j = 0; j < 8; ++j) { v[j] = dr[64 * j]; s += (v[j].x * v[j].x + v[j].y * v[j].y) + (v[j].z * v[j].z + v[j].w * v[j].w); }
        const float rstd = 1.0f / sqrtf(wave_sum(s) * (1.f / D_MODEL) + RMS_EPS);
#pragma unroll
        for (int j = 0; j < 8; ++j) { const f32x4 gg = g1[64 * j]; orow[64 * j] = orow[64 * j] + v[j] * rstd * gg; }
    }
}

extern "C" void kernel_launch(void* const* d_in, const int* in_sizes, int n_in, void* d_out, int out_size, void* d_ws, size_t ws_size, hipStream_t stream) {
    static int grid_blocks = 0;
    if (grid_blocks == 0) {
        if (n_in != 20 || in_sizes[0] != M_TOK * D_MODEL || out_size != M_TOK * D_MODEL || ws_size < WS_END) {
            fprintf(stderr, "kernel_launch: unexpected shapes: n_in %d in0 %d out %d ws %zu (need %zu)\n", n_in, n_in > 0 ? in_sizes[0] : -1, out_size, ws_size, (size_t)WS_END); grid_blocks = -1; return; }
        int dev = 0, cus = 0, per_cu = 0;
        (void)hipGetDevice(&dev);
        (void)hipDeviceGetAttribute(&cus, hipDeviceAttributeMultiprocessorCount, dev);
        if (hipFuncSetAttribute((const void*)fwd_megakernel, hipFuncAttributeMaxDynamicSharedMemorySize, LDS_BYTES) != hipSuccess) fprintf(stderr, "kernel_launch: hipFuncSetAttribute failed\n");
        if (hipOccupancyMaxActiveBlocksPerMultiprocessor(&per_cu, (const void*)fwd_megakernel, 512, LDS_BYTES) != hipSuccess || per_cu < 1) { fprintf(stderr, "kernel_launch: occupancy query gave %d\n", per_cu); per_cu = 1; }
        (void)hipGetLastError();
        grid_blocks = cus * per_cu;
    }
    if (grid_blocks < 0) return;
    Args a{};
    a.x = (const float*)d_in[0]; a.pos = (const int*)d_in[1]; a.g_pre = (const float*)d_in[2]; a.w_in = (const float*)d_in[3]; a.conv_w = (const float*)d_in[4]; a.conv_b = (const float*)d_in[5];
    a.w_rg_a = (const float*)d_in[6]; a.b_rg_a = (const float*)d_in[7]; a.w_rg_x = (const float*)d_in[8]; a.b_rg_x = (const float*)d_in[9]; a.lam = (const float*)d_in[10]; a.sinks = (const float*)d_in[11];
    a.w_rnn = (const float*)d_in[12]; a.w_attn = (const float*)d_in[13]; a.w_out = (const float*)d_in[14]; a.g_post = (const float*)d_in[15]; a.g_mlp_pre = (const float*)d_in[16];
    a.w_up = (const float*)d_in[17]; a.w_down = (const float*)d_in[18]; a.g_mlp_post = (const float*)d_in[19];
    a.out = (float*)d_out; a.ws = (unsigned char*)d_ws;
    if (hipMemsetAsync((char*)d_ws + WS_CTL, 0, 256, stream) != hipSuccess) { fprintf(stderr, "kernel_launch: memset failed\n"); return; }
    void* args[] = {&a};
    hipError_t e = hipLaunchCooperativeKernel((const void*)fwd_megakernel, dim3(grid_blocks), dim3(512), args, LDS_BYTES, stream);
    if (e != hipSuccess) fprintf(stderr, "cooperative launch failed: %s (grid %d)\n", hipGetErrorString(e), grid_blocks);
}
```

```cpp
#include <hip/hip_runtime.h>
#include <hip/hip_cooperative_groups.h>
#include <cstdio>
#include <cstdint>
namespace cg = cooperative_groups;

#define LAS __attribute__((address_space(3)))
typedef unsigned short bf16_t;
typedef short bf16x8 __attribute__((ext_vector_type(8)));
typedef short s16x4 __attribute__((ext_vector_type(4)));
typedef float f32x4 __attribute__((ext_vector_type(4)));
typedef float f32x2 __attribute__((ext_vector_type(2)));
typedef float f32x16 __attribute__((ext_vector_type(16)));
typedef unsigned u32x4 __attribute__((ext_vector_type(4)));
typedef unsigned u32x2 __attribute__((ext_vector_type(2)));

constexpr int D_MODEL = 2048, BATCH = 4, SEQ = 8192, M_TOK = BATCH * SEQ;
constexpr int D_RNN = 2048, D_FF = 8192, D_IN = 10752;
constexpr int OFF_XR = 0, OFF_YR = 2048, OFF_Q = 4096, OFF_K = 6144, OFF_V = 6400, OFF_GR = 6656, OFF_GA = 8704;
constexpr float RMS_EPS = 1e-6f;
constexpr float LOG2E = 1.4426950408889634f;

constexpr size_t MiB = 1u << 20;
constexpr size_t WS_COS = 0, WS_SIN = 4 * MiB, WS_SUMA = 8 * MiB, WS_SUMB = 10 * MiB, WS_HIN = 12 * MiB;
constexpr size_t WS_WRGA = 14 * MiB, WS_WRGX = 15 * MiB, WS_WIN = 16 * MiB, WS_WRNN = 58 * MiB, WS_WATT = 66 * MiB, WS_WOUT = 74 * MiB;
constexpr size_t WS_WUP = 82 * MiB, WS_WDN = 114 * MiB, WS_P = 146 * MiB, WS_H = 818 * MiB, WS_U = 146 * MiB, WS_D = 658 * MiB, WS_CTL = 946 * MiB, WS_END = 947 * MiB;

constexpr int LDS_BYTES = 147456;
#ifndef REP_G
#define REP_G 1
#endif
#ifndef REP_A
#define REP_A 1
#endif
#ifndef REP_B
#define REP_B 1
#endif
#ifndef REP_C
#define REP_C 1
#endif

typedef __bf16 bf16x2_t __attribute__((ext_vector_type(2)));
__device__ __forceinline__ unsigned cvt_pk_bf16(float lo, float hi) { const f32x2 v = {lo, hi}; const bf16x2_t b = __builtin_convertvector(v, bf16x2_t); return __builtin_bit_cast(unsigned, b); }
__device__ __forceinline__ float bf2f(unsigned short b) { return __uint_as_float(((unsigned)b) << 16); }
__device__ __forceinline__ float bflo(unsigned w) { return __uint_as_float(w << 16); }
__device__ __forceinline__ float bfhi(unsigned w) { return __uint_as_float(w & 0xffff0000u); }
__device__ __forceinline__ float sigmoidf_(float v) { return __builtin_amdgcn_rcpf(1.0f + __builtin_amdgcn_exp2f(-v * LOG2E)); }
__device__ __forceinline__ float gelu_tanh(float v) { const float u = 1.5957691216057308f * (v + 0.044715f * v * v * v); return v * sigmoidf_(u); }
__device__ __forceinline__ float wave_sum(float v) {
#pragma unroll
    for (int o = 1; o < 64; o <<= 1) v += __shfl_xor(v, o);
    return v;
}

namespace pg8 {
constexpr int BM = 256, BK = 64, HALF = 128, HTB = HALF * BK * 2, STAGE_BYTES = 8 * HTB, NXCD = 8, WGM = 8;
__host__ __device__ __forceinline__ int lds_byte(int r, int c) { const int st = (r >> 4) * 2 + (c >> 5), rr = r & 15, cc = c & 31, ob = rr * 64 + cc * 2; return st * 1024 + (ob ^ (((ob >> 9) & 1) << 5)); }
__host__ __device__ __forceinline__ void stage_rc(int b, int& R, int& C) { const int st = b / 1024, sb = b % 1024, swz = sb ^ (((sb >> 9) & 1) << 5); R = (st >> 1) * 16 + swz / 64; C = (st & 1) * 32 + (swz % 64) / 2; }
__host__ __device__ __forceinline__ int perm32(int rho) { const int n = rho >> 4, i = rho & 15; return 8 * (i >> 2) + 4 * n + (i & 3); }

struct Unit { int pm, pn; };
struct Gemm { const bf16_t* A; const bf16_t* Bt; int M, N, K, lda; };

struct StaticOrder {
    int nM, nN, nwg, G, c;
    __device__ void init(int M, int N, int G_, int c_) { nM = M / BM; nN = N / BM; nwg = nM * nN; G = G_; c = c_; }
    __device__ bool next(int i, Unit& u) const {
        const long L = (long)i * G + c; if (L >= nwg) return false;
        int wgid = (int)L; { const int q = nwg / NXCD, r = nwg % NXCD, xcd = wgid % NXCD, off = wgid / NXCD; wgid = (xcd < r ? xcd * (q + 1) : r * (q + 1) + (xcd - r) * q) + off; }
        const int nig = WGM * nN, gid = wgid / nig, fm = gid * WGM, gsz = (nM - fm) < WGM ? (nM - fm) : WGM;
        u.pm = fm + ((wgid % nig) % gsz); u.pn = (wgid % nig) / gsz; return true;
    }
};

struct EpiBf16 {
    static constexpr bool PERM = true;
    bf16_t* O; int ldc; int mode;
    template <int ACT> __device__ __forceinline__ void run(const f32x4 (&acc)[2][2][4][2], const Unit& u, int wr, int wc, int fr, int fq) const {
        const int row0 = u.pm * BM + wr * 64 + fr, col0 = u.pn * BM + wc * 32 + 8 * fq;
#pragma unroll
        for (int ai = 0; ai < 2; ++ai)
#pragma unroll
            for (int m = 0; m < 4; ++m) { bf16_t* rowp = O + (size_t)(row0 + ai * HALF + m * 16) * ldc + col0;
#pragma unroll
                for (int bj = 0; bj < 2; ++bj) { f32x4 v0 = acc[ai][bj][m][0], v1 = acc[ai][bj][m][1];
#pragma unroll
                    for (int e = 0; e < 4; ++e) {
                        if (ACT == 1) { v0[e] = gelu_tanh(v0[e]); v1[e] = gelu_tanh(v1[e]); }
                        if (ACT == 2) { v0[e] = sigmoidf_(v0[e]); v1[e] = sigmoidf_(v1[e]); }
                        if (ACT == 3) { const float a0 = fmaxf(v0[e], 0.f), a1 = fmaxf(v1[e], 0.f); v0[e] = a0 * a0; v1[e] = a1 * a1; }
                    }
                    u32x4 w; w.x = cvt_pk_bf16(v0[0], v0[1]); w.y = cvt_pk_bf16(v0[2], v0[3]); w.z = cvt_pk_bf16(v1[0], v1[1]); w.w = cvt_pk_bf16(v1[2], v1[3]);
                    *(u32x4*)(rowp + bj * HALF) = w; } }
    }
    __device__ __forceinline__ void operator()(const f32x4 (&acc)[2][2][4][2], const Unit& u, int wr, int wc, int fr, int fq) const {
        if (mode == 3) { run<3>(acc, u, wr, wc, fr, fq); return; }
        if (mode == 4) { run<0>(acc, u, wr, wc, fr, fq); return; }
        const int seg = u.pn;
        if (seg >= 8 && seg < 16) run<1>(acc, u, wr, wc, fr, fq);
        else if (seg >= 26) run<2>(acc, u, wr, wc, fr, fq);
        else run<0>(acc, u, wr, wc, fr, fq);
    }
};
struct EpiGate {
    static constexpr bool PERM = true;
    bf16_t* G; const bf16_t* P; int ld;
    __device__ __forceinline__ void operator()(const f32x4 (&acc)[2][2][4][2], const Unit& u, int wr, int wc, int fr, int fq) const {
        const int row0 = u.pm * BM + wr * 64 + fr, col0 = u.pn * BM + wc * 32 + 8 * fq;
#pragma unroll
        for (int ai = 0; ai < 2; ++ai)
#pragma unroll
            for (int m = 0; m < 4; ++m) { const size_t ro = (size_t)(row0 + ai * HALF + m * 16) * ld + col0;
#pragma unroll
                for (int bj = 0; bj < 2; ++bj) { const f32x4 v0 = acc[ai][bj][m][0], v1 = acc[ai][bj][m][1];
                    const u32x4 g = *(const u32x4*)(G + ro + bj * HALF);
                    float o[8];
                    o[0] = bflo(g.x) * v0[0]; o[1] = bfhi(g.x) * v0[1]; o[2] = bflo(g.y) * v0[2]; o[3] = bfhi(g.y) * v0[3];
                    o[4] = bflo(g.z) * v1[0]; o[5] = bfhi(g.z) * v1[1]; o[6] = bflo(g.w) * v1[2]; o[7] = bfhi(g.w) * v1[3];
                    if (P) { const u32x4 p = *(const u32x4*)(P + ro + bj * HALF);
                        o[0] += bflo(p.x); o[1] += bfhi(p.x); o[2] += bflo(p.y); o[3] += bfhi(p.y); o[4] += bflo(p.z); o[5] += bfhi(p.z); o[6] += bflo(p.w); o[7] += bfhi(p.w); }
                    u32x4 w; w.x = cvt_pk_bf16(o[0], o[1]); w.y = cvt_pk_bf16(o[2], o[3]); w.z = cvt_pk_bf16(o[4], o[5]); w.w = cvt_pk_bf16(o[6], o[7]);
                    *(u32x4*)(G + ro + bj * HALF) = w; } }
    }
};
struct EpiF32 {
    static constexpr bool PERM = false;
    float* O; int ldc;
    __device__ __forceinline__ void operator()(const f32x4 (&acc)[2][2][4][2], const Unit& u, int wr, int wc, int fr, int fq) const {
        const int row0 = u.pm * BM + wr * 64 + fr, col0 = u.pn * BM + wc * 32 + 4 * fq;
#pragma unroll
        for (int ai = 0; ai < 2; ++ai)
#pragma unroll
            for (int m = 0; m < 4; ++m) { float* rowp = O + (size_t)(row0 + ai * HALF + m * 16) * ldc + col0;
#pragma unroll
                for (int bj = 0; bj < 2; ++bj)
#pragma unroll
                    for (int n = 0; n < 2; ++n) *(f32x4*)(rowp + bj * HALF + n * 16) = acc[ai][bj][m][n]; }
    }
};

template <class Epi>
__device__ __forceinline__ void gemm_phase(LAS unsigned char* lds, const Gemm g, const StaticOrder& S, const Epi& E) {
    int tid_ = threadIdx.x; asm volatile("" : "+v"(tid_));
    const int tid = tid_, wid = __builtin_amdgcn_readfirstlane(tid >> 6), lane = tid & 63, wr = wid >> 2, wc = wid & 3, fr = lane & 15, fq = lane >> 4;
    const int K = g.K, nt = K / BK, lda = g.lda;
    unsigned voffA[2], voffB[2];
#pragma unroll
    for (int i = 0; i < 2; ++i) { int R, C; stage_rc(tid * 16 + i * 8192, R, C); const int Rb = Epi::PERM ? ((R & ~31) + perm32(R & 31)) : R;
        voffA[i] = (unsigned)(R * lda + C) * 2u; voffB[i] = (unsigned)(Rb * K + C) * 2u; }
    const size_t kstep = (size_t)(BK * 2);
    const size_t hstepA = (size_t)HALF * lda * 2, hstepB = (size_t)HALF * K * 2;
    const size_t tstepA = 2 * hstepA, tstepB = 2 * hstepB;
    const unsigned ldsw = (unsigned)wid * 1024u;
    const int aoff = lds_byte(wr * 64 + fr, fq * 8), boff = lds_byte(wc * 32 + fr, fq * 8);
#define PG8_SA(b, h) (((b) * 2 + (h)) * HTB)
#define PG8_SB(b, h) ((4 + (b) * 2 + (h)) * HTB)
#define PG8_STAGE(bufoff, gbase, voff) do { _Pragma("unroll") for (int _i = 0; _i < 2; ++_i) \
        __builtin_amdgcn_global_load_lds((const unsigned*)((const char*)(gbase) + (voff)[_i]), (LAS unsigned*)(lds + (bufoff) + ldsw + _i * 8192), 16, 0, 0); } while (0)
#define PG8_LDA(dst, b, h) do { _Pragma("unroll") for (int m = 0; m < 4; ++m) _Pragma("unroll") for (int k = 0; k < 2; ++k) dst[m][k] = *(const LAS bf16x8*)(lds + PG8_SA(b, h) + aoff + m * 2048 + k * 1024); } while (0)
#define PG8_LDB(dst, b, h) do { _Pragma("unroll") for (int n = 0; n < 2; ++n) _Pragma("unroll") for (int k = 0; k < 2; ++k) dst[n][k] = *(const LAS bf16x8*)(lds + PG8_SB(b, h) + boff + n * 2048 + k * 1024); } while (0)
#define PG8_MMA(ai, bj, At, Bt) do { __builtin_amdgcn_s_setprio(1); _Pragma("unroll") for (int m = 0; m < 4; ++m) _Pragma("unroll") for (int n = 0; n < 2; ++n) _Pragma("unroll") for (int k = 0; k < 2; ++k) \
        acc[ai][bj][m][n] = __builtin_amdgcn_mfma_f32_16x16x32_bf16(Bt[n][k], At[m][k], acc[ai][bj][m][n], 0, 0, 0); __builtin_amdgcn_s_setprio(0); } while (0)
#define PG8_WAIT_V(n) asm volatile("s_waitcnt vmcnt(" #n ")" ::: "memory")
#define PG8_WAIT_L(n) asm volatile("s_waitcnt lgkmcnt(" #n ")" ::: "memory")
#define PG8_BAR __builtin_amdgcn_s_barrier()
#define PG8_SCHED __builtin_amdgcn_sched_barrier(0)
    Unit cur, nxt; int ui = 0;
    if (!S.next(0, cur)) return;
    f32x4 acc[2][2][4][2];
#pragma unroll
    for (int a = 0; a < 2; ++a)
#pragma unroll
        for (int b = 0; b < 2; ++b)
#pragma unroll
            for (int m = 0; m < 4; ++m)
#pragma unroll
                for (int n = 0; n < 2; ++n) acc[a][b][m][n] = (f32x4){0.f, 0.f, 0.f, 0.f};
    bf16x8 At[4][2], B0[2][2], B1[2][2];
    const char* cA = (const char*)g.A + (size_t)cur.pm * tstepA; const char* cB = (const char*)g.Bt + (size_t)cur.pn * tstepB;
    PG8_STAGE(PG8_SB(0, 0), cB, voffB); PG8_STAGE(PG8_SB(0, 1), cB + hstepB, voffB); PG8_STAGE(PG8_SA(0, 0), cA, voffA); PG8_STAGE(PG8_SA(0, 1), cA + hstepA, voffA);
    if (wr == 1) PG8_BAR;
    PG8_WAIT_V(2); PG8_BAR;
    PG8_STAGE(PG8_SB(1, 0), cB + kstep, voffB); PG8_STAGE(PG8_SA(1, 0), cA + kstep, voffA); PG8_STAGE(PG8_SB(1, 1), cB + hstepB + kstep, voffB);
    PG8_WAIT_V(6); PG8_BAR;
    for (;;) {
        const bool has_next = S.next(ui + 1, nxt);
        const char* nA = has_next ? (const char*)g.A + (size_t)nxt.pm * tstepA : cA; const char* nB = has_next ? (const char*)g.Bt + (size_t)nxt.pn * tstepB : cB;
        for (int t = 0; t < nt; t += 2) {
            const bool last = (t == nt - 2);
            const char* a1 = cA + (size_t)(t + 1) * kstep;
            const char* a2 = last ? nA : cA + (size_t)(t + 2) * kstep; const char* b2 = last ? nB : cB + (size_t)(t + 2) * kstep;
            const char* a3 = a2 + kstep; const char* b3 = b2 + kstep;
            PG8_LDB(B0, 0, 0); PG8_LDB(B1, 0, 1); PG8_SCHED; PG8_LDA(At, 0, 0); PG8_STAGE(PG8_SA(1, 1), a1 + hstepA, voffA);
            PG8_WAIT_V(8); PG8_WAIT_L(0); PG8_BAR; PG8_MMA(0, 0, At, B0); PG8_MMA(0, 1, At, B1); PG8_BAR; PG8_SCHED;
            PG8_LDA(At, 0, 1); PG8_STAGE(PG8_SB(0, 0), b2, voffB); PG8_STAGE(PG8_SB(0, 1), b2 + hstepB, voffB); PG8_STAGE(PG8_SA(0, 0), a2, voffA);
            PG8_WAIT_V(8); PG8_WAIT_L(0); PG8_BAR; PG8_MMA(1, 0, At, B0); PG8_MMA(1, 1, At, B1); PG8_BAR; PG8_SCHED;
            PG8_LDB(B0, 1, 0); PG8_LDB(B1, 1, 1); PG8_SCHED; PG8_LDA(At, 1, 0); PG8_STAGE(PG8_SA(0, 1), a2 + hstepA, voffA);
            PG8_WAIT_V(8); PG8_WAIT_L(0); PG8_BAR; PG8_MMA(0, 0, At, B0); PG8_MMA(0, 1, At, B1); PG8_BAR; PG8_SCHED;
            PG8_LDA(At, 1, 1); PG8_STAGE(PG8_SB(1, 0), b3, voffB); PG8_STAGE(PG8_SB(1, 1), b3 + hstepB, voffB); PG8_STAGE(PG8_SA(1, 0), a3, voffA);
            PG8_WAIT_V(8); PG8_WAIT_L(0); PG8_BAR; PG8_MMA(1, 0, At, B0); PG8_MMA(1, 1, At, B1); PG8_BAR; PG8_SCHED;
        }
        if (wr == 0) PG8_BAR;
        E(acc, cur, wr, wc, fr, fq);
        if (!has_next) break;
#pragma unroll
        for (int a = 0; a < 2; ++a)
#pragma unroll
            for (int b = 0; b < 2; ++b)
#pragma unroll
                for (int m = 0; m < 4; ++m)
#pragma unroll
                    for (int n = 0; n < 2; ++n) acc[a][b][m][n] = (f32x4){0.f, 0.f, 0.f, 0.f};
        cur = nxt; cA = nA; cB = nB; ++ui;
        if (wr == 1) PG8_BAR;
    }
    PG8_WAIT_V(0);
    PG8_BAR;
#undef PG8_SA
#undef PG8_SB
#undef PG8_STAGE
#undef PG8_LDA
#undef PG8_LDB
#undef PG8_MMA
#undef PG8_WAIT_V
#undef PG8_WAIT_L
#undef PG8_BAR
#undef PG8_SCHED
}
}

struct Args {
    const float* x; const int* pos; const float* g_pre; const float* w_in; const float* conv_w; const float* conv_b;
    const float* w_rg_a; const float* b_rg_a; const float* w_rg_x; const float* b_rg_x; const float* lam; const float* sinks;
    const float* w_rnn; const float* w_attn; const float* w_out; const float* g_post; const float* g_mlp_pre;
    const float* w_up; const float* w_down; const float* g_mlp_post;
    float* out; unsigned char* ws;
};

__device__ __forceinline__ void p0_transpose_item(const float* W, int K, int N, bf16_t* WT, LAS float* scr, int item, int lane) {
    const int nblk = N / 32, kb = item / nblk, nb = item % nblk, k0 = 64 * kb, n0 = 32 * nb;
#pragma unroll 8
    for (int i = 0; i < 32; ++i) { const int kk = 2 * i + (lane >> 5); scr[kk * 33 + (lane & 31)] = W[(size_t)(k0 + kk) * N + n0 + (lane & 31)]; }
    asm volatile("s_waitcnt lgkmcnt(0)" ::: "memory");
    const int c = lane & 7;
#pragma unroll
    for (int j = 0; j < 4; ++j) { const int n = (lane >> 3) + 8 * j; const LAS float* s = scr + (8 * c) * 33 + n;
        u32x4 o; o.x = cvt_pk_bf16(s[0 * 33], s[1 * 33]); o.y = cvt_pk_bf16(s[2 * 33], s[3 * 33]); o.z = cvt_pk_bf16(s[4 * 33], s[5 * 33]); o.w = cvt_pk_bf16(s[6 * 33], s[7 * 33]);
        *(u32x4*)(WT + (size_t)(n0 + n) * K + k0 + 8 * c) = o; }
    asm volatile("s_waitcnt lgkmcnt(0)" ::: "memory");
}

__device__ __forceinline__ void rms_row_to_bf16(const float* xrow, const float* g, bf16_t* orow, int lane) {
    const f32x4* xr = (const f32x4*)xrow + lane; const f32x4* gr = (const f32x4*)g + lane;
    f32x4 v[8]; float s = 0.f;
#pragma unroll
    for (int j = 0; j < 8; ++j) { v[j] = xr[64 * j]; s += (v[j].x * v[j].x + v[j].y * v[j].y) + (v[j].z * v[j].z + v[j].w * v[j].w); }
    const float rstd = 1.0f / sqrtf(wave_sum(s) * (1.f / D_MODEL) + RMS_EPS);
    u32x2* o8 = (u32x2*)orow + lane;
#pragma unroll
    for (int j = 0; j < 8; ++j) { const f32x4 gg = gr[64 * j]; u32x2 w; w.x = cvt_pk_bf16(v[j].x * rstd * gg.x, v[j].y * rstd * gg.y); w.y = cvt_pk_bf16(v[j].z * rstd * gg.z, v[j].w * rstd * gg.w); o8[64 * j] = w; }
}

constexpr int XC_LD = 264;
constexpr int XC_BYTES = 128 * XC_LD * 2;
__device__ __forceinline__ void rnn_tile(const Args& a, LAS unsigned char* lds, int tile, int nblk) {
    int tid_ = threadIdx.x; asm volatile("" : "+v"(tid_));
    const int tid = tid_, lane = tid & 63, w = __builtin_amdgcn_readfirstlane(tid >> 6), hi = lane >> 5, l32 = lane & 31;
    bf16_t* proj = (bf16_t*)(a.ws + WS_P);
    bf16_t* qbuf = (bf16_t*)a.out;
    LAS bf16_t* xc = (LAS bf16_t*)lds;
    LAS bf16_t* yg = (LAS bf16_t*)(lds + XC_BYTES);
    LAS unsigned* rmask = (LAS unsigned*)(lds + 2 * XC_BYTES);
    const int tok0 = tile * 128, sidx0 = (tile & 63) * 128;
#pragma unroll
    for (int i = 0; i < 8; ++i) { const int p = tid + 512 * i, row = p >> 5, c16 = p & 31;
        *(LAS u32x4*)(yg + row * XC_LD + c16 * 8) = *(const u32x4*)(proj + (size_t)(tok0 + row) * D_IN + OFF_YR + nblk * 256 + c16 * 8); }
    {
        const int cgp = tid & 31, ts = tid >> 5, ch = nblk * 256 + cgp * 8;
        float wk[4][8], bb[8];
#pragma unroll
        for (int k = 0; k < 4; ++k) { const f32x4 w0 = *(const f32x4*)(a.conv_w + k * D_RNN + ch), w1 = *(const f32x4*)(a.conv_w + k * D_RNN + ch + 4);
            wk[k][0] = w0.x; wk[k][1] = w0.y; wk[k][2] = w0.z; wk[k][3] = w0.w; wk[k][4] = w1.x; wk[k][5] = w1.y; wk[k][6] = w1.z; wk[k][7] = w1.w; }
        { const f32x4 b0 = *(const f32x4*)(a.conv_b + ch), b1 = *(const f32x4*)(a.conv_b + ch + 4); bb[0] = b0.x; bb[1] = b0.y; bb[2] = b0.z; bb[3] = b0.w; bb[4] = b1.x; bb[5] = b1.y; bb[6] = b1.z; bb[7] = b1.w; }
        u32x4 raw[11];
#pragma unroll
        for (int j = 0; j < 11; ++j) { const int tl = ts * 8 + j - 3;
            if (sidx0 + tl >= 0) raw[j] = *(const u32x4*)(proj + (size_t)(tok0 + tl) * D_IN + OFF_XR + ch); else raw[j] = (u32x4){0u, 0u, 0u, 0u}; }
#pragma unroll
        for (int j = 0; j < 8; ++j) { float y[8];
#pragma unroll
            for (int e = 0; e < 8; ++e) y[e] = bb[e];
#pragma unroll
            for (int k = 0; k < 4; ++k) { const u32x4 r = raw[j + k];
                y[0] += wk[k][0] * bflo(r.x); y[1] += wk[k][1] * bfhi(r.x); y[2] += wk[k][2] * bflo(r.y); y[3] += wk[k][3] * bfhi(r.y);
                y[4] += wk[k][4] * bflo(r.z); y[5] += wk[k][5] * bfhi(r.z); y[6] += wk[k][6] * bflo(r.w); y[7] += wk[k][7] * bfhi(r.w); }
            u32x4 o; o.x = cvt_pk_bf16(y[0], y[1]); o.y = cvt_pk_bf16(y[2], y[3]); o.z = cvt_pk_bf16(y[4], y[5]); o.w = cvt_pk_bf16(y[6], y[7]);
            *(LAS u32x4*)(xc + (ts * 8 + j) * XC_LD + cgp * 8) = o; }
        if (tid < 128) { const bool z = (a.pos[tok0 + tid] == 0); const unsigned long long bal = __ballot(z); if (lane == 0) { rmask[2 * w] = (unsigned)bal; rmask[2 * w + 1] = (unsigned)(bal >> 32); } }
    }
    __syncthreads();
    const int cl = w * 32 + l32, c = nblk * 256 + cl;
    const bf16_t* wa = (const bf16_t*)(a.ws + WS_WRGA) + (size_t)nblk * 65536 + (size_t)cl * 256 + 8 * hi;
    const bf16_t* wx = (const bf16_t*)(a.ws + WS_WRGX) + (size_t)nblk * 65536 + (size_t)cl * 256 + 8 * hi;
    f32x16 ga[4], gx[4];
#pragma unroll
    for (int mb = 0; mb < 4; ++mb)
#pragma unroll
        for (int i = 0; i < 16; ++i) { ga[mb][i] = 0.f; gx[mb][i] = 0.f; }
    bf16x8 fa[4], fx[4];
#pragma unroll
    for (int p = 0; p < 3; ++p) { fa[p] = *(const bf16x8*)(wa + 16 * p); fx[p] = *(const bf16x8*)(wx + 16 * p); }
#pragma unroll
    for (int kk = 0; kk < 16; ++kk) {
        if (kk + 3 < 16) { fa[(kk + 3) & 3] = *(const bf16x8*)(wa + 16 * (kk + 3)); fx[(kk + 3) & 3] = *(const bf16x8*)(wx + 16 * (kk + 3)); }
#pragma unroll
        for (int mb = 0; mb < 4; ++mb) {
            const bf16x8 af = *(const LAS bf16x8*)(xc + (32 * mb + l32) * XC_LD + 16 * kk + 8 * hi);
            ga[mb] = __builtin_amdgcn_mfma_f32_32x32x16_bf16(af, fa[kk & 3], ga[mb], 0, 0, 0);
            gx[mb] = __builtin_amdgcn_mfma_f32_32x32x16_bf16(af, fx[kk & 3], gx[mb], 0, 0, 0);
        }
    }
    const float bav = a.b_rg_a[c], bxv = a.b_rg_x[c];
    const float nsp = -8.0f * LOG2E * log1pf(expf(-a.lam[c]));
    float H = 0.f, C = 1.f;
#pragma unroll
    for (int mb = 0; mb < 4; ++mb) {
        const unsigned mw = rmask[mb];
        float av[16], bv[16];
#pragma unroll
        for (int i = 0; i < 16; ++i) {
            const int row = 8 * (i >> 2) + 4 * hi + (i & 3);
            const float r = sigmoidf_(ga[mb][i] + bav), ig = sigmoidf_(gx[mb][i] + bxv);
            float aa = __builtin_amdgcn_exp2f(nsp * r);
            float mult = sqrtf(fmaxf(fmaf(-aa, aa, 1.0f), 0.f));
            if ((mw >> row) & 1u) { aa = 0.f; mult = 1.f; }
            const float xv = bf2f(xc[(32 * mb + row) * XC_LD + cl]);
            av[i] = aa; bv[i] = mult * ig * xv;
        }
#pragma unroll
        for (int g = 0; g < 4; ++g) {
            const float As = (av[4 * g] * av[4 * g + 1]) * (av[4 * g + 2] * av[4 * g + 3]);
            const float Bs = ((bv[4 * g] * av[4 * g + 1] + bv[4 * g + 1]) * av[4 * g + 2] + bv[4 * g + 2]) * av[4 * g + 3] + bv[4 * g + 3];
            const float Ao = __shfl_xor(As, 32), Bo = __shfl_xor(Bs, 32);
            const float Alo = hi ? Ao : As, Blo = hi ? Bo : Bs, Ahi = hi ? As : Ao, Bhi = hi ? Bs : Bo;
            float hs = hi ? (H * Alo + Blo) : H, cs = hi ? (C * Alo) : C;
#pragma unroll
            for (int j = 0; j < 4; ++j) { hs = av[4 * g + j] * hs + bv[4 * g + j]; cs *= av[4 * g + j];
                const int li = (32 * mb + 8 * g + 4 * hi + j) * XC_LD + cl;
                const float gy = bf2f(yg[li]);
                xc[li] = (bf16_t)(cvt_pk_bf16(hs * gy, 0.f) & 0xffffu); yg[li] = (bf16_t)(cvt_pk_bf16(cs * gy, 0.f) & 0xffffu); }
            H = (H * Alo + Blo) * Ahi + Bhi; C *= Alo * Ahi;
        }
    }
    if (hi == 0) { ((float*)(a.ws + WS_SUMA))[(size_t)tile * D_RNN + c] = C; ((float*)(a.ws + WS_SUMB))[(size_t)tile * D_RNN + c] = H; }
    __syncthreads();
#pragma unroll
    for (int i = 0; i < 8; ++i) { const int p = tid + 512 * i, row = p >> 5, c16 = p & 31;
        *(u32x4*)(proj + (size_t)(tok0 + row) * D_IN + OFF_YR + nblk * 256 + c16 * 8) = *(const LAS u32x4*)(xc + row * XC_LD + c16 * 8);
        *(u32x4*)(qbuf + (size_t)(tok0 + row) * D_RNN + nblk * 256 + c16 * 8) = *(const LAS u32x4*)(yg + row * XC_LD + c16 * 8); }
    __syncthreads();
}
__device__ __forceinline__ void rnn_fixup(const Args& a, int bx, int G) {
    bf16_t* proj = (bf16_t*)(a.ws + WS_P); const bf16_t* qbuf = (const bf16_t*)a.out; const float* hin = (const float*)(a.ws + WS_HIN);
    int tid_ = threadIdx.x; asm volatile("" : "+v"(tid_));
    for (int idx = bx * 512 + tid_; idx < M_TOK * 256; idx += G * 512) {
        const int row = idx >> 8, c8 = (idx & 255) * 8, tile = row >> 7;
        bf16_t* pp = proj + (size_t)row * D_IN + OFF_YR + c8;
        const u32x4 p = *(const u32x4*)pp, q = *(const u32x4*)(qbuf + (size_t)row * D_RNN + c8);
        const f32x4 h0 = *(const f32x4*)(hin + (size_t)tile * D_RNN + c8), h1 = *(const f32x4*)(hin + (size_t)tile * D_RNN + c8 + 4);
        u32x4 o;
        o.x = cvt_pk_bf16(bflo(p.x) + bflo(q.x) * h0.x, bfhi(p.x) + bfhi(q.x) * h0.y); o.y = cvt_pk_bf16(bflo(p.y) + bflo(q.y) * h0.z, bfhi(p.y) + bfhi(q.y) * h0.w);
        o.z = cvt_pk_bf16(bflo(p.z) + bflo(q.z) * h1.x, bfhi(p.z) + bfhi(q.z) * h1.y); o.w = cvt_pk_bf16(bflo(p.w) + bflo(q.w) * h1.z, bfhi(p.w) + bfhi(q.w) * h1.w);
        *(u32x4*)pp = o;
    }
}

constexpr int KS_LD = 72, VT_LD = 264, VT_OFF = 256 * KS_LD * 2;
__device__ __forceinline__ void attn_item(const Args& a, LAS unsigned char* lds, int item) {
    int tid_ = threadIdx.x; asm volatile("" : "+v"(tid_));
    const int tid = tid_, lane = tid & 63, w = __builtin_amdgcn_readfirstlane(tid >> 6), hi = lane >> 5, l32 = lane & 31;
    const int b = item >> 8, nb = (item >> 2) & 63, hk = item & 3;
    bf16_t* proj = (bf16_t*)(a.ws + WS_P);
    const float* tcos = (const float*)(a.ws + WS_COS); const float* tsin = (const float*)(a.ws + WS_SIN);
    LAS bf16_t* Ks = (LAS bf16_t*)lds; LAS bf16_t* Vt = (LAS bf16_t*)(lds + VT_OFF);
    const int tok0 = b * SEQ + nb * 128;
    {
        const int key = tid >> 1, part = tid & 1;
        if (nb == 0 && key < 128) {
            const u32x4 z = (u32x4){0u, 0u, 0u, 0u};
            *(LAS u32x4*)(Ks + key * KS_LD + 16 * part) = z; *(LAS u32x4*)(Ks + key * KS_LD + 16 * part + 8) = z;
            *(LAS u32x4*)(Ks + key * KS_LD + 32 + 16 * part) = z; *(LAS u32x4*)(Ks + key * KS_LD + 32 + 16 * part + 8) = z;
#pragma unroll
            for (int e = 0; e < 32; ++e) Vt[(32 * part + e) * VT_LD + key] = 0;
        } else {
            const int tok = tok0 - 128 + key;
            const bf16_t* ksrc = proj + (size_t)tok * D_IN + OFF_K + hk * 64 + 16 * part;
            const u32x4 x1a = *(const u32x4*)(ksrc), x1b = *(const u32x4*)(ksrc + 8), x2a = *(const u32x4*)(ksrc + 32), x2b = *(const u32x4*)(ksrc + 40);
            float x1[16], x2[16], cs[16], sn[16];
            x1[0] = bflo(x1a.x); x1[1] = bfhi(x1a.x); x1[2] = bflo(x1a.y); x1[3] = bfhi(x1a.y); x1[4] = bflo(x1a.z); x1[5] = bfhi(x1a.z); x1[6] = bflo(x1a.w); x1[7] = bfhi(x1a.w);
            x1[8] = bflo(x1b.x); x1[9] = bfhi(x1b.x); x1[10] = bflo(x1b.y); x1[11] = bfhi(x1b.y); x1[12] = bflo(x1b.z); x1[13] = bfhi(x1b.z); x1[14] = bflo(x1b.w); x1[15] = bfhi(x1b.w);
            x2[0] = bflo(x2a.x); x2[1] = bfhi(x2a.x); x2[2] = bflo(x2a.y); x2[3] = bfhi(x2a.y); x2[4] = bflo(x2a.z); x2[5] = bfhi(x2a.z); x2[6] = bflo(x2a.w); x2[7] = bfhi(x2a.w);
            x2[8] = bflo(x2b.x); x2[9] = bfhi(x2b.x); x2[10] = bflo(x2b.y); x2[11] = bfhi(x2b.y); x2[12] = bflo(x2b.z); x2[13] = bfhi(x2b.z); x2[14] = bflo(x2b.w); x2[15] = bfhi(x2b.w);
#pragma unroll
            for (int q4 = 0; q4 < 4; ++q4) { const f32x4 cv = *(const f32x4*)(tcos + (size_t)tok * 32 + 16 * part + 4 * q4), sv = *(const f32x4*)(tsin + (size_t)tok * 32 + 16 * part + 4 * q4);
                cs[4 * q4] = cv.x; cs[4 * q4 + 1] = cv.y; cs[4 * q4 + 2] = cv.z; cs[4 * q4 + 3] = cv.w; sn[4 * q4] = sv.x; sn[4 * q4 + 1] = sv.y; sn[4 * q4 + 2] = sv.z; sn[4 * q4 + 3] = sv.w; }
            float o1[16], o2[16];
#pragma unroll
            for (int e = 0; e < 16; ++e) { o1[e] = x1[e] * cs[e] - x2[e] * sn[e]; o2[e] = x2[e] * cs[e] + x1[e] * sn[e]; }
            u32x4 wv;
            wv.x = cvt_pk_bf16(o1[0], o1[1]); wv.y = cvt_pk_bf16(o1[2], o1[3]); wv.z = cvt_pk_bf16(o1[4], o1[5]); wv.w = cvt_pk_bf16(o1[6], o1[7]); *(LAS u32x4*)(Ks + key * KS_LD + 16 * part) = wv;
            wv.x = cvt_pk_bf16(o1[8], o1[9]); wv.y = cvt_pk_bf16(o1[10], o1[11]); wv.z = cvt_pk_bf16(o1[12], o1[13]); wv.w = cvt_pk_bf16(o1[14], o1[15]); *(LAS u32x4*)(Ks + key * KS_LD + 16 * part + 8) = wv;
            wv.x = cvt_pk_bf16(o2[0], o2[1]); wv.y = cvt_pk_bf16(o2[2], o2[3]); wv.z = cvt_pk_bf16(o2[4], o2[5]); wv.w = cvt_pk_bf16(o2[6], o2[7]); *(LAS u32x4*)(Ks + key * KS_LD + 32 + 16 * part) = wv;
            wv.x = cvt_pk_bf16(o2[8], o2[9]); wv.y = cvt_pk_bf16(o2[10], o2[11]); wv.z = cvt_pk_bf16(o2[12], o2[13]); wv.w = cvt_pk_bf16(o2[14], o2[15]); *(LAS u32x4*)(Ks + key * KS_LD + 32 + 16 * part + 8) = wv;
            const bf16_t* vsrc = proj + (size_t)tok * D_IN + OFF_V + hk * 64 + 32 * part;
#pragma unroll
            for (int q4 = 0; q4 < 4; ++q4) { const u32x4 vv = *(const u32x4*)(vsrc + 8 * q4); LAS bf16_t* vd = Vt + (32 * part + 8 * q4) * VT_LD + key;
                vd[0 * VT_LD] = (bf16_t)(vv.x & 0xffffu); vd[1 * VT_LD] = (bf16_t)(vv.x >> 16); vd[2 * VT_LD] = (bf16_t)(vv.y & 0xffffu); vd[3 * VT_LD] = (bf16_t)(vv.y >> 16);
                vd[4 * VT_LD] = (bf16_t)(vv.z & 0xffffu); vd[5 * VT_LD] = (bf16_t)(vv.z >> 16); vd[6 * VT_LD] = (bf16_t)(vv.w & 0xffffu); vd[7 * VT_LD] = (bf16_t)(vv.w >> 16); }
        }
    }
    __syncthreads();
    const int hq = hk * 8 + w;
    const float sink2 = a.sinks[hq] * LOG2E;
    const float CS = 0.125f * LOG2E;
#pragma unroll 1
    for (int qq = 0; qq < 4; ++qq) {
        const int tokq = tok0 + 32 * qq + l32;
        const bf16_t* qsrc = proj + (size_t)tokq * D_IN + OFF_Q + hq * 64;
        bf16_t* osrc = (bf16_t*)(a.ws + WS_H) + (size_t)tokq * 2048 + hq * 64;
        bf16x8 qf[4];
        {
            u32x4 raw[4];
#pragma unroll
            for (int dd = 0; dd < 4; ++dd) raw[dd] = *(const u32x4*)(qsrc + 16 * dd + 8 * hi);
#pragma unroll
            for (int d2 = 0; d2 < 2; ++d2) {
                const float* cp = tcos + (size_t)tokq * 32 + 16 * d2 + 8 * hi; const float* sp = tsin + (size_t)tokq * 32 + 16 * d2 + 8 * hi;
                const f32x4 c0 = *(const f32x4*)cp, c1 = *(const f32x4*)(cp + 4), s0 = *(const f32x4*)sp, s1 = *(const f32x4*)(sp + 4);
                const float cs[8] = {c0.x, c0.y, c0.z, c0.w, c1.x, c1.y, c1.z, c1.w}, sn[8] = {s0.x, s0.y, s0.z, s0.w, s1.x, s1.y, s1.z, s1.w};
                const u32x4 r1 = raw[d2], r2 = raw[d2 + 2];
                const float x1[8] = {bflo(r1.x), bfhi(r1.x), bflo(r1.y), bfhi(r1.y), bflo(r1.z), bfhi(r1.z), bflo(r1.w), bfhi(r1.w)};
                const float x2[8] = {bflo(r2.x), bfhi(r2.x), bflo(r2.y), bfhi(r2.y), bflo(r2.z), bfhi(r2.z), bflo(r2.w), bfhi(r2.w)};
                float o1[8], o2[8];
#pragma unroll
                for (int e = 0; e < 8; ++e) { o1[e] = x1[e] * cs[e] - x2[e] * sn[e]; o2[e] = x2[e] * cs[e] + x1[e] * sn[e]; }
                u32x4 w1, w2;
                w1.x = cvt_pk_bf16(o1[0], o1[1]); w1.y = cvt_pk_bf16(o1[2], o1[3]); w1.z = cvt_pk_bf16(o1[4], o1[5]); w1.w = cvt_pk_bf16(o1[6], o1[7]);
                w2.x = cvt_pk_bf16(o2[0], o2[1]); w2.y = cvt_pk_bf16(o2[2], o2[3]); w2.z = cvt_pk_bf16(o2[4], o2[5]); w2.w = cvt_pk_bf16(o2[6], o2[7]);
                qf[d2] = __builtin_bit_cast(bf16x8, w1); qf[d2 + 2] = __builtin_bit_cast(bf16x8, w2);
            }
        }
        f32x16 s[5];
#pragma unroll
        for (int kbi = 0; kbi < 5; ++kbi) {
#pragma unroll
            for (int i = 0; i < 16; ++i) s[kbi][i] = 0.f;
            const LAS bf16_t* kp = Ks + (32 * (qq + kbi) + l32) * KS_LD + 8 * hi;
#pragma unroll
            for (int dd = 0; dd < 4; ++dd) { const bf16x8 kf = *(const LAS bf16x8*)(kp + 16 * dd); s[kbi] = __builtin_amdgcn_mfma_f32_32x32x16_bf16(kf, qf[dd], s[kbi], 0, 0, 0); }
        }
        float mx = -1e30f;
#pragma unroll
        for (int kbi = 0; kbi < 5; ++kbi) {
            const bool blk_ok = !(nb == 0 && qq + kbi < 4);
#pragma unroll
            for (int i = 0; i < 16; ++i) { const int row = 8 * (i >> 2) + 4 * hi + (i & 3);
                bool ok = blk_ok; if (kbi == 0) ok = ok && (row > l32); if (kbi == 4) ok = ok && (row <= l32);
                const float v = ok ? s[kbi][i] * CS : -1e30f; s[kbi][i] = v; mx = fmaxf(mx, v); }
        }
        mx = fmaxf(mx, __shfl_xor(mx, 32)); mx = fmaxf(mx, sink2);
        float lsum = 0.f;
        bf16x8 pk[5][2];
#pragma unroll
        for (int kbi = 0; kbi < 5; ++kbi) {
#pragma unroll
            for (int i = 0; i < 16; ++i) { const float p = __builtin_amdgcn_exp2f(s[kbi][i] - mx); s[kbi][i] = p; lsum += p; }
#pragma unroll
            for (int j2 = 0; j2 < 2; ++j2) { u32x4 pw;
                pw.x = cvt_pk_bf16(s[kbi][8 * j2 + 0], s[kbi][8 * j2 + 1]); pw.y = cvt_pk_bf16(s[kbi][8 * j2 + 2], s[kbi][8 * j2 + 3]);
                pw.z = cvt_pk_bf16(s[kbi][8 * j2 + 4], s[kbi][8 * j2 + 5]); pw.w = cvt_pk_bf16(s[kbi][8 * j2 + 6], s[kbi][8 * j2 + 7]);
                pk[kbi][j2] = __builtin_bit_cast(bf16x8, pw); }
        }
        lsum += __shfl_xor(lsum, 32); lsum += __builtin_amdgcn_exp2f(sink2 - mx);
        const float inv = 1.0f / lsum;
        f32x16 o[2];
#pragma unroll
        for (int db = 0; db < 2; ++db)
#pragma unroll
            for (int i = 0; i < 16; ++i) o[db][i] = 0.f;
#pragma unroll
        for (int kbi = 0; kbi < 5; ++kbi)
#pragma unroll
            for (int j2 = 0; j2 < 2; ++j2)
#pragma unroll
                for (int db = 0; db < 2; ++db) {
                    const LAS bf16_t* vp = Vt + (32 * db + l32) * VT_LD + 32 * (qq + kbi) + 16 * j2 + 4 * hi;
                    const s16x4 lo = *(const LAS s16x4*)vp, hh = *(const LAS s16x4*)(vp + 8);
                    const bf16x8 vf = (bf16x8){lo[0], lo[1], lo[2], lo[3], hh[0], hh[1], hh[2], hh[3]};
                    o[db] = __builtin_amdgcn_mfma_f32_32x32x16_bf16(vf, pk[kbi][j2], o[db], 0, 0, 0);
                }
#pragma unroll
        for (int db = 0; db < 2; ++db)
#pragma unroll
            for (int g = 0; g < 4; ++g) { u32x2 wv; wv.x = cvt_pk_bf16(o[db][4 * g] * inv, o[db][4 * g + 1] * inv); wv.y = cvt_pk_bf16(o[db][4 * g + 2] * inv, o[db][4 * g + 3] * inv);
                *(u32x2*)(osrc + 32 * db + 8 * g + 4 * hi) = wv; }
    }
    __syncthreads();
}

__device__ __forceinline__ void grid_barrier(unsigned* ctr, unsigned target) {
    asm volatile("s_waitcnt vmcnt(0) lgkmcnt(0)" ::: "memory");
    __syncthreads();
    if (threadIdx.x == 0) {
        __builtin_amdgcn_fence(__ATOMIC_RELEASE, "agent");
        asm volatile("s_waitcnt vmcnt(0)" ::: "memory");
        __hip_atomic_fetch_add(ctr, 1u, __ATOMIC_RELAXED, __HIP_MEMORY_SCOPE_AGENT);
        while (__hip_atomic_load(ctr, __ATOMIC_RELAXED, __HIP_MEMORY_SCOPE_AGENT) < target) __builtin_amdgcn_s_sleep(2);
        __builtin_amdgcn_fence(__ATOMIC_ACQUIRE, "agent");
        asm volatile("s_waitcnt vmcnt(0)" ::: "memory");
    }
    __syncthreads();
}
#define GRID_SYNC() do { ++bar_k; grid_barrier(bar_ctr, bar_k * (unsigned)gridDim.x); } while (0)
__global__ void __launch_bounds__(512, 2) fwd_megakernel(Args a) {
    extern __shared__ __attribute__((aligned(16))) unsigned char lds_raw[];
    LAS unsigned char* lds = (LAS unsigned char*)lds_raw;
    cg::grid_group grid = cg::this_grid();
    const int tid = threadIdx.x, lane = tid & 63, wave = __builtin_amdgcn_readfirstlane(tid >> 6);
    const int G = gridDim.x, bx = blockIdx.x;
    const int gw = bx * 8 + wave, NGW = G * 8;
    bf16_t* proj = (bf16_t*)(a.ws + WS_P);
    bf16_t* Hb = (bf16_t*)(a.ws + WS_H);
    unsigned* bar_ctr = (unsigned*)(a.ws + WS_CTL); unsigned bar_k = 0;
    grid.sync();

    for (int rep_ = 0; rep_ < REP_A; ++rep_) {
    {
        LAS float* scr = (LAS float*)(lds + wave * 16384);
        constexpr int I_IN = (D_MODEL / 64) * (D_IN / 32), I_SQ = (2048 / 64) * (2048 / 32), I_UP = (D_MODEL / 64) * (D_FF / 32), I_DN = (D_FF / 64) * (D_MODEL / 32), I_RG = 8 * 32;
        constexpr int NITEMS = I_IN + 3 * I_SQ + I_UP + I_DN + 2 * I_RG;
        for (int it = gw; it < NITEMS; it += NGW) {
            int r = it;
            if (r < I_IN) { p0_transpose_item(a.w_in, D_MODEL, D_IN, (bf16_t*)(a.ws + WS_WIN), scr, r, lane); continue; } r -= I_IN;
            if (r < I_SQ) { p0_transpose_item(a.w_rnn, 2048, 2048, (bf16_t*)(a.ws + WS_WRNN), scr, r, lane); continue; } r -= I_SQ;
            if (r < I_SQ) { p0_transpose_item(a.w_attn, 2048, 2048, (bf16_t*)(a.ws + WS_WATT), scr, r, lane); continue; } r -= I_SQ;
            if (r < I_SQ) { p0_transpose_item(a.w_out, 2048, 2048, (bf16_t*)(a.ws + WS_WOUT), scr, r, lane); continue; } r -= I_SQ;
            if (r < I_UP) { p0_transpose_item(a.w_up, D_MODEL, D_FF, (bf16_t*)(a.ws + WS_WUP), scr, r, lane); continue; } r -= I_UP;
            if (r < I_DN) { p0_transpose_item(a.w_down, D_FF, D_MODEL, (bf16_t*)(a.ws + WS_WDN), scr, r, lane); continue; } r -= I_DN;
            if (r < I_RG) { const int nb = r >> 5; p0_transpose_item(a.w_rg_a + (size_t)nb * 65536, 256, 256, (bf16_t*)(a.ws + WS_WRGA) + (size_t)nb * 65536, scr, r & 31, lane); continue; } r -= I_RG;
            { const int nb = r >> 5; p0_transpose_item(a.w_rg_x + (size_t)nb * 65536, 256, 256, (bf16_t*)(a.ws + WS_WRGX) + (size_t)nb * 65536, scr, r & 31, lane); }
        }
        for (int m = gw; m < M_TOK; m += NGW) rms_row_to_bf16(a.x + (size_t)m * D_MODEL, a.g_pre, Hb + (size_t)m * D_MODEL, lane);
        float* tcos = (float*)(a.ws + WS_COS); float* tsin = (float*)(a.ws + WS_SIN);
        for (int i = bx * 512 + tid; i < M_TOK * 32; i += G * 512) {
            const int tok = i >> 5, f = i & 31;
            const float inv_freq = exp2f(-(float)f * (13.287712379549449f / 32.0f));
            const float ang = (float)a.pos[tok] * inv_freq;
            float sv, cv; sincosf(ang, &sv, &cv); tcos[i] = cv; tsin[i] = sv;
        }
    }
    GRID_SYNC();
    }
    for (int rep_ = 0; rep_ < REP_G; ++rep_) {
    {
        pg8::Gemm g{Hb, (const bf16_t*)(a.ws + WS_WIN), M_TOK, D_IN, D_MODEL, D_MODEL}; pg8::StaticOrder S; S.init(M_TOK, D_IN, G, bx);
        pg8::EpiBf16 E{proj, D_IN, 0};
        pg8::gemm_phase<pg8::EpiBf16>(lds, g, S, E);
    }
    GRID_SYNC();
    }
    for (int rep_ = 0; rep_ < REP_B; ++rep_) {
    for (int it = bx; it < 256 * 8; it += G) rnn_tile(a, lds, it >> 3, it & 7);
    GRID_SYNC();
    }
    for (int rep_ = 0; rep_ < REP_C; ++rep_) {
    {
        if (tid < 32) {
            const int gi = bx * 32 + tid;
            if (gi < BATCH * D_RNN) {
                const int b = gi / D_RNN, ch = gi % D_RNN;
                const float* sa = (const float*)(a.ws + WS_SUMA) + (size_t)b * 64 * D_RNN + ch; const float* sb = (const float*)(a.ws + WS_SUMB) + (size_t)b * 64 * D_RNN + ch;
                float* hin = (float*)(a.ws + WS_HIN) + (size_t)b * 64 * D_RNN + ch;
                float H = 0.f;
                for (int j0 = 0; j0 < 64; j0 += 8) {
                    float av[8], bv[8];
#pragma unroll
                    for (int j = 0; j < 8; ++j) { av[j] = sa[(size_t)(j0 + j) * D_RNN]; bv[j] = sb[(size_t)(j0 + j) * D_RNN]; }
#pragma unroll
                    for (int j = 0; j < 8; ++j) { hin[(size_t)(j0 + j) * D_RNN] = H; H = H * av[j] + bv[j]; }
                }
            }
        }
        for (int it = bx; it < 1024; it += G) attn_item(a, lds, it);
    }
    GRID_SYNC();
    }
    rnn_fixup(a, bx, G);
    GRID_SYNC();
    {
        pg8::StaticOrder S; S.init(M_TOK, D_MODEL, G, bx);
        { pg8::Gemm g{proj + OFF_YR, (const bf16_t*)(a.ws + WS_WRNN), M_TOK, D_MODEL, D_RNN, D_IN};
          pg8::EpiGate E{proj + OFF_GR, nullptr, D_IN}; pg8::gemm_phase<pg8::EpiGate>(lds, g, S, E); }
        { pg8::Gemm g{Hb, (const bf16_t*)(a.ws + WS_WATT), M_TOK, D_MODEL, 2048, 2048};
          pg8::EpiGate E{proj + OFF_GA, proj + OFF_GR, D_IN}; pg8::gemm_phase<pg8::EpiGate>(lds, g, S, E); }
    }
    GRID_SYNC();
    for (int rep_ = 0; rep_ < REP_G; ++rep_) {
    {
        pg8::Gemm g{proj + OFF_GA, (const bf16_t*)(a.ws + WS_WOUT), M_TOK, D_MODEL, D_MODEL, D_IN}; pg8::StaticOrder S; S.init(M_TOK, D_MODEL, G, bx);
        pg8::EpiBf16 E{proj + OFF_XR, D_IN, 4}; pg8::gemm_phase<pg8::EpiBf16>(lds, g, S, E);
    }
    GRID_SYNC();
    }
    for (int m = gw; m < M_TOK; m += NGW) {
        f32x4* tr = (f32x4*)(a.out + (size_t)m * D_MODEL) + lane; const f32x4* xr = (const f32x4*)(a.x + (size_t)m * D_MODEL) + lane;
        const u32x2* tb = (const u32x2*)(proj + (size_t)m * D_IN + OFF_XR) + lane;
        const f32x4* g1 = (const f32x4*)a.g_post + lane; const f32x4* g2 = (const f32x4*)a.g_mlp_pre + lane;
        f32x4 v[8]; float s = 0.f;
#pragma unroll
        for (int j = 0; j < 8; ++j) { const u32x2 t2 = tb[64 * j]; v[j] = (f32x4){bflo(t2.x), bfhi(t2.x), bflo(t2.y), bfhi(t2.y)}; s += (v[j].x * v[j].x + v[j].y * v[j].y) + (v[j].z * v[j].z + v[j].w * v[j].w); }
        const float rstd = 1.0f / sqrtf(wave_sum(s) * (1.f / D_MODEL) + RMS_EPS);
        float s2 = 0.f;
#pragma unroll
        for (int j = 0; j < 8; ++j) { const f32x4 xx = xr[64 * j], gg = g1[64 * j]; v[j] = xx + v[j] * rstd * gg; tr[64 * j] = v[j]; s2 += (v[j].x * v[j].x + v[j].y * v[j].y) + (v[j].z * v[j].z + v[j].w * v[j].w); }
        const float rstd2 = 1.0f / sqrtf(wave_sum(s2) * (1.f / D_MODEL) + RMS_EPS);
        u32x2* o8 = (u32x2*)(Hb + (size_t)m * D_MODEL) + lane;
#pragma unroll
        for (int j = 0; j < 8; ++j) { const f32x4 gg = g2[64 * j]; u32x2 w; w.x = cvt_pk_bf16(v[j].x * rstd2 * gg.x, v[j].y * rstd2 * gg.y); w.y = cvt_pk_bf16(v[j].z * rstd2 * gg.z, v[j].w * rstd2 * gg.w); o8[64 * j] = w; }
    }
    GRID_SYNC();
    for (int rep_ = 0; rep_ < REP_G; ++rep_) {
    {
        pg8::Gemm g{Hb, (const bf16_t*)(a.ws + WS_WUP), M_TOK, D_FF, D_MODEL, D_MODEL}; pg8::StaticOrder S; S.init(M_TOK, D_FF, G, bx);
        pg8::EpiBf16 E{(bf16_t*)(a.ws + WS_U), D_FF, 3}; pg8::gemm_phase<pg8::EpiBf16>(lds, g, S, E);
    }
    GRID_SYNC();
    }
    for (int rep_ = 0; rep_ < REP_G; ++rep_) {
    {
        pg8::Gemm g{(const bf16_t*)(a.ws + WS_U), (const bf16_t*)(a.ws + WS_WDN), M_TOK, D_MODEL, D_FF, D_FF}; pg8::StaticOrder S; S.init(M_TOK, D_MODEL, G, bx);
        pg8::EpiBf16 E{(bf16_t*)(a.ws + WS_D), D_MODEL, 4}; pg8::gemm_phase<pg8::EpiBf16>(lds, g, S, E);
    }
    GRID_SYNC();
    }
    for (int m = gw; m < M_TOK; m += NGW) {
        f32x4* orow = (f32x4*)(a.out + (size_t)m * D_MODEL) + lane; const u32x2* dr = (const u32x2*)((const bf16_t*)(a.ws + WS_D) + (size_t)m * D_MODEL) + lane;
        const f32x4* g1 = (const f32x4*)a.g_mlp_post + lane;
        f32x4 v[8]; float s = 0.f;
#pragma unroll
        for (int j = 0; j < 8; ++j) { const u32x2 t2 = dr[64 * j]; v[j] = (f32x4){bflo(t2.x), bfhi(t2.x), bflo(t2.y), bfhi(t2.y)}; s += (v[j].x * v[j].x + v[j].y * v[j].y) + (v[j].z * v[j].z + v[j].w * v[j].w); }
        const float rstd = 1.0f / sqrtf(wave_sum(s) * (1.f / D_MODEL) + RMS_EPS);
#pragma unroll
        for (int j = 0; j < 8; ++j) { const f32x4 gg = g1[64 * j]; orow[64 * j] = orow[64 * j] + v[j] * rstd * gg; }
    }
}

extern "C" void kernel_launch(void* const* d_in, const int* in_sizes, int n_in, void* d_out, int out_size, void* d_ws, size_t ws_size, hipStream_t stream) {
    static int grid_blocks = 0;
    if (grid_blocks == 0) {
        if (n_in != 20 || in_sizes[0] != M_TOK * D_MODEL || out_size != M_TOK * D_MODEL || ws_size < WS_END) {
            fprintf(stderr, "kernel_launch: unexpected shapes: n_in %d in0 %d out %d ws %zu (need %zu)\n", n_in, n_in > 0 ? in_sizes[0] : -1, out_size, ws_size, (size_t)WS_END); grid_blocks = -1; return; }
        int dev = 0, cus = 0, per_cu = 0;
        (void)hipGetDevice(&dev);
        (void)hipDeviceGetAttribute(&cus, hipDeviceAttributeMultiprocessorCount, dev);
        if (hipFuncSetAttribute((const void*)fwd_megakernel, hipFuncAttributeMaxDynamicSharedMemorySize, LDS_BYTES) != hipSuccess) fprintf(stderr, "kernel_launch: hipFuncSetAttribute failed\n");
        if (hipOccupancyMaxActiveBlocksPerMultiprocessor(&per_cu, (const void*)fwd_megakernel, 512, LDS_BYTES) != hipSuccess || per_cu < 1) { fprintf(stderr, "kernel_launch: occupancy query gave %d\n", per_cu); per_cu = 1; }
        (void)hipGetLastError();
        grid_blocks = cus * per_cu;
    }
    if (grid_blocks < 0) return;
    Args a{};
    a.x = (const float*)d_in[0]; a.pos = (const int*)d_in[1]; a.g_pre = (const float*)d_in[2]; a.w_in = (const float*)d_in[3]; a.conv_w = (const float*)d_in[4]; a.conv_b = (const float*)d_in[5];
    a.w_rg_a = (const float*)d_in[6]; a.b_rg_a = (const float*)d_in[7]; a.w_rg_x = (const float*)d_in[8]; a.b_rg_x = (const float*)d_in[9]; a.lam = (const float*)d_in[10]; a.sinks = (const float*)d_in[11];
    a.w_rnn = (const float*)d_in[12]; a.w_attn = (const float*)d_in[13]; a.w_out = (const float*)d_in[14]; a.g_post = (const float*)d_in[15]; a.g_mlp_pre = (const float*)d_in[16];
    a.w_up = (const float*)d_in[17]; a.w_down = (const float*)d_in[18]; a.g_mlp_post = (const float*)d_in[19];
    a.out = (float*)d_out; a.ws = (unsigned char*)d_ws;
    if (hipMemsetAsync((char*)d_ws + WS_CTL, 0, 256, stream) != hipSuccess) { fprintf(stderr, "kernel_launch: memset failed\n"); return; }
    void* args[] = {&a};
    hipError_t e = hipLaunchCooperativeKernel((const void*)fwd_megakernel, dim3(grid_blocks), dim3(512), args, LDS_BYTES, stream);
    if (e != hipSuccess) fprintf(stderr, "cooperative launch failed: %s (grid %d)\n", hipGetErrorString(e), grid_blocks);
}
```

```cpp
#include <hip/hip_runtime.h>
#include <hip/hip_cooperative_groups.h>
#include <cstdio>
#include <cstdint>
namespace cg = cooperative_groups;

#define LAS __attribute__((address_space(3)))
typedef unsigned short bf16_t;
typedef short bf16x8 __attribute__((ext_vector_type(8)));
typedef short s16x4 __attribute__((ext_vector_type(4)));
typedef float f32x4 __attribute__((ext_vector_type(4)));
typedef float f32x2 __attribute__((ext_vector_type(2)));
typedef float f32x16 __attribute__((ext_vector_type(16)));
typedef unsigned u32x4 __attribute__((ext_vector_type(4)));
typedef unsigned u32x2 __attribute__((ext_vector_type(2)));

constexpr int D_MODEL = 2048, BATCH = 4, SEQ = 8192, M_TOK = BATCH * SEQ;
constexpr int D_RNN = 2048, D_FF = 8192, D_IN = 10752;
constexpr int OFF_XR = 0, OFF_YR = 2048, OFF_Q = 4096, OFF_K = 6144, OFF_V = 6400, OFF_GR = 6656, OFF_GA = 8704;
constexpr float RMS_EPS = 1e-6f;
constexpr float LOG2E = 1.4426950408889634f;

constexpr size_t MiB = 1u << 20;
constexpr size_t WS_COS = 0, WS_SIN = 4 * MiB, WS_SUMA = 8 * MiB, WS_SUMB = 10 * MiB, WS_HIN = 12 * MiB;
constexpr size_t WS_WRGA = 14 * MiB, WS_WRGX = 15 * MiB, WS_WIN = 16 * MiB, WS_WRNN = 58 * MiB, WS_WATT = 66 * MiB, WS_WOUT = 74 * MiB;
constexpr size_t WS_WUP = 82 * MiB, WS_WDN = 114 * MiB, WS_P = 146 * MiB, WS_H = 818 * MiB, WS_U = 146 * MiB, WS_D = 658 * MiB, WS_CTL = 946 * MiB, WS_END = 947 * MiB;

constexpr int LDS_BYTES = 147456;
#ifndef REP_G
#define REP_G 1
#endif
#ifndef REP_A
#define REP_A 1
#endif
#ifndef REP_B
#define REP_B 1
#endif
#ifndef REP_C
#define REP_C 1
#endif

typedef __bf16 bf16x2_t __attribute__((ext_vector_type(2)));
__device__ __forceinline__ unsigned cvt_pk_bf16(float lo, float hi) { const f32x2 v = {lo, hi}; const bf16x2_t b = __builtin_convertvector(v, bf16x2_t); return __builtin_bit_cast(unsigned, b); }
__device__ __forceinline__ float bf2f(unsigned short b) { return __uint_as_float(((unsigned)b) << 16); }
__device__ __forceinline__ float bflo(unsigned w) { return __uint_as_float(w << 16); }
__device__ __forceinline__ float bfhi(unsigned w) { return __uint_as_float(w & 0xffff0000u); }
__device__ __forceinline__ float sigmoidf_(float v) { return __builtin_amdgcn_rcpf(1.0f + __builtin_amdgcn_exp2f(-v * LOG2E)); }
__device__ __forceinline__ float gelu_tanh(float v) { const float u = 1.5957691216057308f * (v + 0.044715f * v * v * v); return v * sigmoidf_(u); }
__device__ __forceinline__ float wave_sum(float v) {
#pragma unroll
    for (int o = 1; o < 64; o <<= 1) v += __shfl_xor(v, o);
    return v;
}

namespace pg8 {
constexpr int BM = 256, BK = 64, HALF = 128, HTB = HALF * BK * 2, STAGE_BYTES = 8 * HTB, NXCD = 8, WGM = 8;
__host__ __device__ __forceinline__ int lds_byte(int r, int c) { const int st = (r >> 4) * 2 + (c >> 5), rr = r & 15, cc = c & 31, ob = rr * 64 + cc * 2; return st * 1024 + (ob ^ (((ob >> 9) & 1) << 5)); }
__host__ __device__ __forceinline__ void stage_rc(int b, int& R, int& C) { const int st = b / 1024, sb = b % 1024, swz = sb ^ (((sb >> 9) & 1) << 5); R = (st >> 1) * 16 + swz / 64; C = (st & 1) * 32 + (swz % 64) / 2; }
__host__ __device__ __forceinline__ int perm32(int rho) { const int n = rho >> 4, i = rho & 15; return 8 * (i >> 2) + 4 * n + (i & 3); }

struct Unit { int pm, pn; };
struct Gemm { const bf16_t* A; const bf16_t* Bt; int M, N, K, lda; };

struct StaticOrder {
    int nM, nN, nwg, G, c;
    __device__ void init(int M, int N, int G_, int c_) { nM = M / BM; nN = N / BM; nwg = nM * nN; G = G_; c = c_; }
    __device__ bool next(int i, Unit& u) const {
        const long L = (long)i * G + c; if (L >= nwg) return false;
        int wgid = (int)L; { const int q = nwg / NXCD, r = nwg % NXCD, xcd = wgid % NXCD, off = wgid / NXCD; wgid = (xcd < r ? xcd * (q + 1) : r * (q + 1) + (xcd - r) * q) + off; }
        const int nig = WGM * nN, gid = wgid / nig, fm = gid * WGM, gsz = (nM - fm) < WGM ? (nM - fm) : WGM;
        u.pm = fm + ((wgid % nig) % gsz); u.pn = (wgid % nig) / gsz; return true;
    }
};

struct EpiBf16 {
    static constexpr bool PERM = true;
    bf16_t* O; int ldc; int mode;
    template <int ACT> __device__ __forceinline__ void run(const f32x4 (&acc)[2][2][4][2], const Unit& u, int wr, int wc, int fr, int fq) const {
        const int row0 = u.pm * BM + wr * 64 + fr, col0 = u.pn * BM + wc * 32 + 8 * fq;
#pragma unroll
        for (int ai = 0; ai < 2; ++ai)
#pragma unroll
            for (int m = 0; m < 4; ++m) { bf16_t* rowp = O + (size_t)(row0 + ai * HALF + m * 16) * ldc + col0;
#pragma unroll
                for (int bj = 0; bj < 2; ++bj) { f32x4 v0 = acc[ai][bj][m][0], v1 = acc[ai][bj][m][1];
#pragma unroll
                    for (int e = 0; e < 4; ++e) {
                        if (ACT == 1) { v0[e] = gelu_tanh(v0[e]); v1[e] = gelu_tanh(v1[e]); }
                        if (ACT == 2) { v0[e] = sigmoidf_(v0[e]); v1[e] = sigmoidf_(v1[e]); }
                        if (ACT == 3) { const float a0 = fmaxf(v0[e], 0.f), a1 = fmaxf(v1[e], 0.f); v0[e] = a0 * a0; v1[e] = a1 * a1; }
                    }
                    u32x4 w; w.x = cvt_pk_bf16(v0[0], v0[1]); w.y = cvt_pk_bf16(v0[2], v0[3]); w.z = cvt_pk_bf16(v1[0], v1[1]); w.w = cvt_pk_bf16(v1[2], v1[3]);
                    *(u32x4*)(rowp + bj * HALF) = w; } }
    }
    __device__ __forceinline__ void operator()(const f32x4 (&acc)[2][2][4][2], const Unit& u, int wr, int wc, int fr, int fq) const {
        if (mode == 3) { run<3>(acc, u, wr, wc, fr, fq); return; }
        if (mode == 4) { run<0>(acc, u, wr, wc, fr, fq); return; }
        const int seg = u.pn;
        if (seg >= 8 && seg < 16) run<1>(acc, u, wr, wc, fr, fq);
        else if (seg >= 26) run<2>(acc, u, wr, wc, fr, fq);
        else run<0>(acc, u, wr, wc, fr, fq);
    }
};
struct EpiGate {
    static constexpr bool PERM = true;
    bf16_t* G; const bf16_t* P; int ld;
    __device__ __forceinline__ void operator()(const f32x4 (&acc)[2][2][4][2], const Unit& u, int wr, int wc, int fr, int fq) const {
        const int row0 = u.pm * BM + wr * 64 + fr, col0 = u.pn * BM + wc * 32 + 8 * fq;
#pragma unroll
        for (int ai = 0; ai < 2; ++ai)
#pragma unroll
            for (int m = 0; m < 4; ++m) { const size_t ro = (size_t)(row0 + ai * HALF + m * 16) * ld + col0;
#pragma unroll
                for (int bj = 0; bj < 2; ++bj) { const f32x4 v0 = acc[ai][bj][m][0], v1 = acc[ai][bj][m][1];
                    const u32x4 g = *(const u32x4*)(G + ro + bj * HALF);
                    float o[8];
                    o[0] = bflo(g.x) * v0[0]; o[1] = bfhi(g.x) * v0[1]; o[2] = bflo(g.y) * v0[2]; o[3] = bfhi(g.y) * v0[3];
                    o[4] = bflo(g.z) * v1[0]; o[5] = bfhi(g.z) * v1[1]; o[6] = bflo(g.w) * v1[2]; o[7] = bfhi(g.w) * v1[3];
                    if (P) { const u32x4 p = *(const u32x4*)(P + ro + bj * HALF);
                        o[0] += bflo(p.x); o[1] += bfhi(p.x); o[2] += bflo(p.y); o[3] += bfhi(p.y); o[4] += bflo(p.z); o[5] += bfhi(p.z); o[6] += bflo(p.w); o[7] += bfhi(p.w); }
                    u32x4 w; w.x = cvt_pk_bf16(o[0], o[1]); w.y = cvt_pk_bf16(o[2], o[3]); w.z = cvt_pk_bf16(o[4], o[5]); w.w = cvt_pk_bf16(o[6], o[7]);
                    *(u32x4*)(G + ro + bj * HALF) = w; } }
    }
};
struct EpiF32 {
    static constexpr bool PERM = false;
    float* O; int ldc;
    __device__ __forceinline__ void operator()(const f32x4 (&acc)[2][2][4][2], const Unit& u, int wr, int wc, int fr, int fq) const {
        const int row0 = u.pm * BM + wr * 64 + fr, col0 = u.pn * BM + wc * 32 + 4 * fq;
#pragma unroll
        for (int ai = 0; ai < 2; ++ai)
#pragma unroll
            for (int m = 0; m < 4; ++m) { float* rowp = O + (size_t)(row0 + ai * HALF + m * 16) * ldc + col0;
#pragma unroll
                for (int bj = 0; bj < 2; ++bj)
#pragma unroll
                    for (int n = 0; n < 2; ++n) *(f32x4*)(rowp + bj * HALF + n * 16) = acc[ai][bj][m][n]; }
    }
};

template <class Epi>
__device__ __forceinline__ void gemm_phase(LAS unsigned char* lds, const Gemm g, const StaticOrder& S, const Epi& E) {
    int tid_ = threadIdx.x; asm volatile("" : "+v"(tid_));
    const int tid = tid_, wid = __builtin_amdgcn_readfirstlane(tid >> 6), lane = tid & 63, wr = wid >> 2, wc = wid & 3, fr = lane & 15, fq = lane >> 4;
    const int K = g.K, nt = K / BK, lda = g.lda;
    unsigned voffA[2], voffB[2];
#pragma unroll
    for (int i = 0; i < 2; ++i) { int R, C; stage_rc(tid * 16 + i * 8192, R, C); const int Rb = Epi::PERM ? ((R & ~31) + perm32(R & 31)) : R;
        voffA[i] = (unsigned)(R * lda + C) * 2u; voffB[i] = (unsigned)(Rb * K + C) * 2u; }
    const size_t kstep = (size_t)(BK * 2);
    const size_t hstepA = (size_t)HALF * lda * 2, hstepB = (size_t)HALF * K * 2;
    const size_t tstepA = 2 * hstepA, tstepB = 2 * hstepB;
    const unsigned ldsw = (unsigned)wid * 1024u;
    const int aoff = lds_byte(wr * 64 + fr, fq * 8), boff = lds_byte(wc * 32 + fr, fq * 8);
#define PG8_SA(b, h) (((b) * 2 + (h)) * HTB)
#define PG8_SB(b, h) ((4 + (b) * 2 + (h)) * HTB)
#define PG8_STAGE(bufoff, gbase, voff) do { _Pragma("unroll") for (int _i = 0; _i < 2; ++_i) \
        __builtin_amdgcn_global_load_lds((const unsigned*)((const char*)(gbase) + (voff)[_i]), (LAS unsigned*)(lds + (bufoff) + ldsw + _i * 8192), 16, 0, 0); } while (0)
#define PG8_LDA(dst, b, h) do { _Pragma("unroll") for (int m = 0; m < 4; ++m) _Pragma("unroll") for (int k = 0; k < 2; ++k) dst[m][k] = *(const LAS bf16x8*)(lds + PG8_SA(b, h) + aoff + m * 2048 + k * 1024); } while (0)
#define PG8_LDB(dst, b, h) do { _Pragma("unroll") for (int n = 0; n < 2; ++n) _Pragma("unroll") for (int k = 0; k < 2; ++k) dst[n][k] = *(const LAS bf16x8*)(lds + PG8_SB(b, h) + boff + n * 2048 + k * 1024); } while (0)
#define PG8_MMA(ai, bj, At, Bt) do { __builtin_amdgcn_s_setprio(1); _Pragma("unroll") for (int m = 0; m < 4; ++m) _Pragma("unroll") for (int n = 0; n < 2; ++n) _Pragma("unroll") for (int k = 0; k < 2; ++k) \
        acc[ai][bj][m][n] = __builtin_amdgcn_mfma_f32_16x16x32_bf16(Bt[n][k], At[m][k], acc[ai][bj][m][n], 0, 0, 0); __builtin_amdgcn_s_setprio(0); } while (0)
#define PG8_WAIT_V(n) asm volatile("s_waitcnt vmcnt(" #n ")" ::: "memory")
#define PG8_WAIT_L(n) asm volatile("s_waitcnt lgkmcnt(" #n ")" ::: "memory")
#define PG8_BAR __builtin_amdgcn_s_barrier()
#define PG8_SCHED __builtin_amdgcn_sched_barrier(0)
    Unit cur, nxt; int ui = 0;
    if (!S.next(0, cur)) return;
    f32x4 acc[2][2][4][2];
#pragma unroll
    for (int a = 0; a < 2; ++a)
#pragma unroll
        for (int b = 0; b < 2; ++b)
#pragma unroll
            for (int m = 0; m < 4; ++m)
#pragma unroll
                for (int n = 0; n < 2; ++n) acc[a][b][m][n] = (f32x4){0.f, 0.f, 0.f, 0.f};
    bf16x8 At[4][2], B0[2][2], B1[2][2];
    const char* cA = (const char*)g.A + (size_t)cur.pm * tstepA; const char* cB = (const char*)g.Bt + (size_t)cur.pn * tstepB;
    PG8_STAGE(PG8_SB(0, 0), cB, voffB); PG8_STAGE(PG8_SB(0, 1), cB + hstepB, voffB); PG8_STAGE(PG8_SA(0, 0), cA, voffA); PG8_STAGE(PG8_SA(0, 1), cA + hstepA, voffA);
    if (wr == 1) PG8_BAR;
    PG8_WAIT_V(2); PG8_BAR;
    PG8_STAGE(PG8_SB(1, 0), cB + kstep, voffB); PG8_STAGE(PG8_SA(1, 0), cA + kstep, voffA); PG8_STAGE(PG8_SB(1, 1), cB + hstepB + kstep, voffB);
    PG8_WAIT_V(6); PG8_BAR;
    for (;;) {
        const bool has_next = S.next(ui + 1, nxt);
        const char* nA = has_next ? (const char*)g.A + (size_t)nxt.pm * tstepA : cA; const char* nB = has_next ? (const char*)g.Bt + (size_t)nxt.pn * tstepB : cB;
        for (int t = 0; t < nt; t += 2) {
            const bool last = (t == nt - 2);
            const char* a1 = cA + (size_t)(t + 1) * kstep;
            const char* a2 = last ? nA : cA + (size_t)(t + 2) * kstep; const char* b2 = last ? nB : cB + (size_t)(t + 2) * kstep;
            const char* a3 = a2 + kstep; const char* b3 = b2 + kstep;
            PG8_LDB(B0, 0, 0); PG8_LDB(B1, 0, 1); PG8_SCHED; PG8_LDA(At, 0, 0); PG8_STAGE(PG8_SA(1, 1), a1 + hstepA, voffA);
            PG8_WAIT_V(8); PG8_WAIT_L(0); PG8_BAR; PG8_MMA(0, 0, At, B0); PG8_MMA(0, 1, At, B1); PG8_BAR; PG8_SCHED;
            PG8_LDA(At, 0, 1); PG8_STAGE(PG8_SB(0, 0), b2, voffB); PG8_STAGE(PG8_SB(0, 1), b2 + hstepB, voffB); PG8_STAGE(PG8_SA(0, 0), a2, voffA);
            PG8_WAIT_V(8); PG8_WAIT_L(0); PG8_BAR; PG8_MMA(1, 0, At, B0); PG8_MMA(1, 1, At, B1); PG8_BAR; PG8_SCHED;
            PG8_LDB(B0, 1, 0); PG8_LDB(B1, 1, 1); PG8_SCHED; PG8_LDA(At, 1, 0); PG8_STAGE(PG8_SA(0, 1), a2 + hstepA, voffA);
            PG8_WAIT_V(8); PG8_WAIT_L(0); PG8_BAR; PG8_MMA(0, 0, At, B0); PG8_MMA(0, 1, At, B1); PG8_BAR; PG8_SCHED;
            PG8_LDA(At, 1, 1); PG8_STAGE(PG8_SB(1, 0), b3, voffB); PG8_STAGE(PG8_SB(1, 1), b3 + hstepB, voffB); PG8_STAGE(PG8_SA(1, 0), a3, voffA);
            PG8_WAIT_V(8); PG8_WAIT_L(0); PG8_BAR; PG8_MMA(1, 0, At, B0); PG8_MMA(1, 1, At, B1); PG8_BAR; PG8_SCHED;
        }
        if (wr == 0) PG8_BAR;
        E(acc, cur, wr, wc, fr, fq);
        if (!has_next) break;
#pragma unroll
        for (int a = 0; a < 2; ++a)
#pragma unroll
            for (int b = 0; b < 2; ++b)
#pragma unroll
                for (int m = 0; m < 4; ++m)
#pragma unroll
                    for (int n = 0; n < 2; ++n) acc[a][b][m][n] = (f32x4){0.f, 0.f, 0.f, 0.f};
        cur = nxt; cA = nA; cB = nB; ++ui;
        if (wr == 1) PG8_BAR;
    }
    PG8_WAIT_V(0);
    PG8_BAR;
#undef PG8_SA
#undef PG8_SB
#undef PG8_STAGE
#undef PG8_LDA
#undef PG8_LDB
#undef PG8_MMA
#undef PG8_WAIT_V
#undef PG8_WAIT_L
#undef PG8_BAR
#undef PG8_SCHED
}
}

struct Args {
    const float* x; const int* pos; const float* g_pre; const float* w_in; const float* conv_w; const float* conv_b;
    const float* w_rg_a; const float* b_rg_a; const float* w_rg_x; const float* b_rg_x; const float* lam; const float* sinks;
    const float* w_rnn; const float* w_attn; const float* w_out; const float* g_post; const float* g_mlp_pre;
    const float* w_up; const float* w_down; const float* g_mlp_post;
    float* out; unsigned char* ws;
};

__device__ __forceinline__ void p0_transpose_item(const float* W, int K, int N, bf16_t* WT, LAS float* scr, int item, int lane) {
    const int nblk = N / 32, kb = item / nblk, nb = item % nblk, k0 = 64 * kb, n0 = 32 * nb;
    float tv[32];
#pragma unroll
    for (int i = 0; i < 32; ++i) tv[i] = W[(size_t)(k0 + 2 * i + (lane >> 5)) * N + n0 + (lane & 31)];
#pragma unroll
    for (int i = 0; i < 32; ++i) scr[(2 * i + (lane >> 5)) * 33 + (lane & 31)] = tv[i];
    asm volatile("s_waitcnt lgkmcnt(0)" ::: "memory");
    const int c = lane & 7;
#pragma unroll
    for (int j = 0; j < 4; ++j) { const int n = (lane >> 3) + 8 * j; const LAS float* s = scr + (8 * c) * 33 + n;
        u32x4 o; o.x = cvt_pk_bf16(s[0 * 33], s[1 * 33]); o.y = cvt_pk_bf16(s[2 * 33], s[3 * 33]); o.z = cvt_pk_bf16(s[4 * 33], s[5 * 33]); o.w = cvt_pk_bf16(s[6 * 33], s[7 * 33]);
        *(u32x4*)(WT + (size_t)(n0 + n) * K + k0 + 8 * c) = o; }
    asm volatile("s_waitcnt lgkmcnt(0)" ::: "memory");
}

__device__ __forceinline__ void rms_row_to_bf16(const float* xrow, const float* g, bf16_t* orow, int lane) {
    const f32x4* xr = (const f32x4*)xrow + lane; const f32x4* gr = (const f32x4*)g + lane;
    f32x4 v[8]; float s = 0.f;
#pragma unroll
    for (int j = 0; j < 8; ++j) { v[j] = xr[64 * j]; s += (v[j].x * v[j].x + v[j].y * v[j].y) + (v[j].z * v[j].z + v[j].w * v[j].w); }
    const float rstd = 1.0f / sqrtf(wave_sum(s) * (1.f / D_MODEL) + RMS_EPS);
    u32x2* o8 = (u32x2*)orow + lane;
#pragma unroll
    for (int j = 0; j < 8; ++j) { const f32x4 gg = gr[64 * j]; u32x2 w; w.x = cvt_pk_bf16(v[j].x * rstd * gg.x, v[j].y * rstd * gg.y); w.y = cvt_pk_bf16(v[j].z * rstd * gg.z, v[j].w * rstd * gg.w); o8[64 * j] = w; }
}

constexpr int XC_LD = 264;
constexpr int XC_BYTES = 128 * XC_LD * 2;
__device__ __forceinline__ void rnn_tile(const Args& a, LAS unsigned char* lds, int tile, int nblk) {
    int tid_ = threadIdx.x; asm volatile("" : "+v"(tid_));
    const int tid = tid_, lane = tid & 63, w = __builtin_amdgcn_readfirstlane(tid >> 6), hi = lane >> 5, l32 = lane & 31;
    bf16_t* proj = (bf16_t*)(a.ws + WS_P);
    bf16_t* qbuf = (bf16_t*)a.out;
    LAS bf16_t* xc = (LAS bf16_t*)lds;
    LAS bf16_t* yg = (LAS bf16_t*)(lds + XC_BYTES);
    LAS unsigned* rmask = (LAS unsigned*)(lds + 2 * XC_BYTES);
    const int tok0 = tile * 128, sidx0 = (tile & 63) * 128;
#pragma unroll
    for (int i = 0; i < 8; ++i) { const int p = tid + 512 * i, row = p >> 5, c16 = p & 31;
        *(LAS u32x4*)(yg + row * XC_LD + c16 * 8) = *(const u32x4*)(proj + (size_t)(tok0 + row) * D_IN + OFF_YR + nblk * 256 + c16 * 8); }
    {
        const int cgp = tid & 31, ts = tid >> 5, ch = nblk * 256 + cgp * 8;
        float wk[4][8], bb[8];
#pragma unroll
        for (int k = 0; k < 4; ++k) { const f32x4 w0 = *(const f32x4*)(a.conv_w + k * D_RNN + ch), w1 = *(const f32x4*)(a.conv_w + k * D_RNN + ch + 4);
            wk[k][0] = w0.x; wk[k][1] = w0.y; wk[k][2] = w0.z; wk[k][3] = w0.w; wk[k][4] = w1.x; wk[k][5] = w1.y; wk[k][6] = w1.z; wk[k][7] = w1.w; }
        { const f32x4 b0 = *(const f32x4*)(a.conv_b + ch), b1 = *(const f32x4*)(a.conv_b + ch + 4); bb[0] = b0.x; bb[1] = b0.y; bb[2] = b0.z; bb[3] = b0.w; bb[4] = b1.x; bb[5] = b1.y; bb[6] = b1.z; bb[7] = b1.w; }
        u32x4 raw[11];
#pragma unroll
        for (int j = 0; j < 11; ++j) { const int tl = ts * 8 + j - 3;
            if (sidx0 + tl >= 0) raw[j] = *(const u32x4*)(proj + (size_t)(tok0 + tl) * D_IN + OFF_XR + ch); else raw[j] = (u32x4){0u, 0u, 0u, 0u}; }
#pragma unroll
        for (int j = 0; j < 8; ++j) { float y[8];
#pragma unroll
            for (int e = 0; e < 8; ++e) y[e] = bb[e];
#pragma unroll
            for (int k = 0; k < 4; ++k) { const u32x4 r = raw[j + k];
                y[0] += wk[k][0] * bflo(r.x); y[1] += wk[k][1] * bfhi(r.x); y[2] += wk[k][2] * bflo(r.y); y[3] += wk[k][3] * bfhi(r.y);
                y[4] += wk[k][4] * bflo(r.z); y[5] += wk[k][5] * bfhi(r.z); y[6] += wk[k][6] * bflo(r.w); y[7] += wk[k][7] * bfhi(r.w); }
            u32x4 o; o.x = cvt_pk_bf16(y[0], y[1]); o.y = cvt_pk_bf16(y[2], y[3]); o.z = cvt_pk_bf16(y[4], y[5]); o.w = cvt_pk_bf16(y[6], y[7]);
            *(LAS u32x4*)(xc + (ts * 8 + j) * XC_LD + cgp * 8) = o; }
        if (tid < 128) { const bool z = (a.pos[tok0 + tid] == 0); const unsigned long long bal = __ballot(z); if (lane == 0) { rmask[2 * w] = (unsigned)bal; rmask[2 * w + 1] = (unsigned)(bal >> 32); } }
    }
    __syncthreads();
    const int cl = w * 32 + l32, c = nblk * 256 + cl;
    const bf16_t* wa = (const bf16_t*)(a.ws + WS_WRGA) + (size_t)nblk * 65536 + (size_t)cl * 256 + 8 * hi;
    const bf16_t* wx = (const bf16_t*)(a.ws + WS_WRGX) + (size_t)nblk * 65536 + (size_t)cl * 256 + 8 * hi;
    f32x16 ga[4], gx[4];
#pragma unroll
    for (int mb = 0; mb < 4; ++mb)
#pragma unroll
        for (int i = 0; i < 16; ++i) { ga[mb][i] = 0.f; gx[mb][i] = 0.f; }
    bf16x8 fa[4], fx[4];
#pragma unroll
    for (int p = 0; p < 3; ++p) { fa[p] = *(const bf16x8*)(wa + 16 * p); fx[p] = *(const bf16x8*)(wx + 16 * p); }
#pragma unroll
    for (int kk = 0; kk < 16; ++kk) {
        if (kk + 3 < 16) { fa[(kk + 3) & 3] = *(const bf16x8*)(wa + 16 * (kk + 3)); fx[(kk + 3) & 3] = *(const bf16x8*)(wx + 16 * (kk + 3)); }
#pragma unroll
        for (int mb = 0; mb < 4; ++mb) {
            const bf16x8 af = *(const LAS bf16x8*)(xc + (32 * mb + l32) * XC_LD + 16 * kk + 8 * hi);
            ga[mb] = __builtin_amdgcn_mfma_f32_32x32x16_bf16(af, fa[kk & 3], ga[mb], 0, 0, 0);
            gx[mb] = __builtin_amdgcn_mfma_f32_32x32x16_bf16(af, fx[kk & 3], gx[mb], 0, 0, 0);
        }
    }
    const float bav = a.b_rg_a[c], bxv = a.b_rg_x[c];
    const float nsp = -8.0f * LOG2E * log1pf(expf(-a.lam[c]));
    float H = 0.f, C = 1.f;
#pragma unroll
    for (int mb = 0; mb < 4; ++mb) {
        const unsigned mw = rmask[mb];
        float av[16], bv[16];
#pragma unroll
        for (int i = 0; i < 16; ++i) {
            const int row = 8 * (i >> 2) + 4 * hi + (i & 3);
            const float r = sigmoidf_(ga[mb][i] + bav), ig = sigmoidf_(gx[mb][i] + bxv);
            float aa = __builtin_amdgcn_exp2f(nsp * r);
            float mult = sqrtf(fmaxf(fmaf(-aa, aa, 1.0f), 0.f));
            if ((mw >> row) & 1u) { aa = 0.f; mult = 1.f; }
            const float xv = bf2f(xc[(32 * mb + row) * XC_LD + cl]);
            av[i] = aa; bv[i] = mult * ig * xv;
        }
#pragma unroll
        for (int g = 0; g < 4; ++g) {
            const float As = (av[4 * g] * av[4 * g + 1]) * (av[4 * g + 2] * av[4 * g + 3]);
            const float Bs = ((bv[4 * g] * av[4 * g + 1] + bv[4 * g + 1]) * av[4 * g + 2] + bv[4 * g + 2]) * av[4 * g + 3] + bv[4 * g + 3];
            const float Ao = __shfl_xor(As, 32), Bo = __shfl_xor(Bs, 32);
            const float Alo = hi ? Ao : As, Blo = hi ? Bo : Bs, Ahi = hi ? As : Ao, Bhi = hi ? Bs : Bo;
            float hs = hi ? (H * Alo + Blo) : H, cs = hi ? (C * Alo) : C;
#pragma unroll
            for (int j = 0; j < 4; ++j) { hs = av[4 * g + j] * hs + bv[4 * g + j]; cs *= av[4 * g + j];
                const int li = (32 * mb + 8 * g + 4 * hi + j) * XC_LD + cl;
                const float gy = bf2f(yg[li]);
                xc[li] = (bf16_t)(cvt_pk_bf16(hs * gy, 0.f) & 0xffffu); yg[li] = (bf16_t)(cvt_pk_bf16(cs * gy, 0.f) & 0xffffu); }
            H = (H * Alo + Blo) * Ahi + Bhi; C *= Alo * Ahi;
        }
    }
    if (hi == 0) { ((float*)(a.ws + WS_SUMA))[(size_t)tile * D_RNN + c] = C; ((float*)(a.ws + WS_SUMB))[(size_t)tile * D_RNN + c] = H; }
    __syncthreads();
#pragma unroll
    for (int i = 0; i < 8; ++i) { const int p = tid + 512 * i, row = p >> 5, c16 = p & 31;
        *(u32x4*)(proj + (size_t)(tok0 + row) * D_IN + OFF_YR + nblk * 256 + c16 * 8) = *(const LAS u32x4*)(xc + row * XC_LD + c16 * 8);
        *(u32x4*)(qbuf + (size_t)(tok0 + row) * D_RNN + nblk * 256 + c16 * 8) = *(const LAS u32x4*)(yg + row * XC_LD + c16 * 8); }
    __syncthreads();
}
__device__ __forceinline__ void rnn_fixup(const Args& a, int bx, int G) {
    bf16_t* proj = (bf16_t*)(a.ws + WS_P); const bf16_t* qbuf = (const bf16_t*)a.out; const float* hin = (const float*)(a.ws + WS_HIN);
    int tid_ = threadIdx.x; asm volatile("" : "+v"(tid_));
    for (int idx = bx * 512 + tid_; idx < M_TOK * 256; idx += G * 512) {
        const int row = idx >> 8, c8 = (idx & 255) * 8, tile = row >> 7;
        bf16_t* pp = proj + (size_t)row * D_IN + OFF_YR + c8;
        const u32x4 p = *(const u32x4*)pp, q = *(const u32x4*)(qbuf + (size_t)row * D_RNN + c8);
        const f32x4 h0 = *(const f32x4*)(hin + (size_t)tile * D_RNN + c8), h1 = *(const f32x4*)(hin + (size_t)tile * D_RNN + c8 + 4);
        u32x4 o;
        o.x = cvt_pk_bf16(bflo(p.x) + bflo(q.x) * h0.x, bfhi(p.x) + bfhi(q.x) * h0.y); o.y = cvt_pk_bf16(bflo(p.y) + bflo(q.y) * h0.z, bfhi(p.y) + bfhi(q.y) * h0.w);
        o.z = cvt_pk_bf16(bflo(p.z) + bflo(q.z) * h1.x, bfhi(p.z) + bfhi(q.z) * h1.y); o.w = cvt_pk_bf16(bflo(p.w) + bflo(q.w) * h1.z, bfhi(p.w) + bfhi(q.w) * h1.w);
        *(u32x4*)pp = o;
    }
}

constexpr int KS_LD = 72, VT_LD = 264, VT_OFF = 256 * KS_LD * 2;
__device__ __forceinline__ void attn_item(const Args& a, LAS unsigned char* lds, int item) {
    int tid_ = threadIdx.x; asm volatile("" : "+v"(tid_));
    const int tid = tid_, lane = tid & 63, w = __builtin_amdgcn_readfirstlane(tid >> 6), hi = lane >> 5, l32 = lane & 31;
    const int b = item >> 8, nb = (item >> 2) & 63, hk = item & 3;
    bf16_t* proj = (bf16_t*)(a.ws + WS_P);
    const float* tcos = (const float*)(a.ws + WS_COS); const float* tsin = (const float*)(a.ws + WS_SIN);
    LAS bf16_t* Ks = (LAS bf16_t*)lds; LAS bf16_t* Vt = (LAS bf16_t*)(lds + VT_OFF);
    const int tok0 = b * SEQ + nb * 128;
    {
        const int key = tid >> 1, part = tid & 1;
        if (nb == 0 && key < 128) {
            const u32x4 z = (u32x4){0u, 0u, 0u, 0u};
            *(LAS u32x4*)(Ks + key * KS_LD + 16 * part) = z; *(LAS u32x4*)(Ks + key * KS_LD + 16 * part + 8) = z;
            *(LAS u32x4*)(Ks + key * KS_LD + 32 + 16 * part) = z; *(LAS u32x4*)(Ks + key * KS_LD + 32 + 16 * part + 8) = z;
#pragma unroll
            for (int e = 0; e < 32; ++e) Vt[(32 * part + e) * VT_LD + key] = 0;
        } else {
            const int tok = tok0 - 128 + key;
            const bf16_t* ksrc = proj + (size_t)tok * D_IN + OFF_K + hk * 64 + 16 * part;
            const u32x4 x1a = *(const u32x4*)(ksrc), x1b = *(const u32x4*)(ksrc + 8), x2a = *(const u32x4*)(ksrc + 32), x2b = *(const u32x4*)(ksrc + 40);
            float x1[16], x2[16], cs[16], sn[16];
            x1[0] = bflo(x1a.x); x1[1] = bfhi(x1a.x); x1[2] = bflo(x1a.y); x1[3] = bfhi(x1a.y); x1[4] = bflo(x1a.z); x1[5] = bfhi(x1a.z); x1[6] = bflo(x1a.w); x1[7] = bfhi(x1a.w);
            x1[8] = bflo(x1b.x); x1[9] = bfhi(x1b.x); x1[10] = bflo(x1b.y); x1[11] = bfhi(x1b.y); x1[12] = bflo(x1b.z); x1[13] = bfhi(x1b.z); x1[14] = bflo(x1b.w); x1[15] = bfhi(x1b.w);
            x2[0] = bflo(x2a.x); x2[1] = bfhi(x2a.x); x2[2] = bflo(x2a.y); x2[3] = bfhi(x2a.y); x2[4] = bflo(x2a.z); x2[5] = bfhi(x2a.z); x2[6] = bflo(x2a.w); x2[7] = bfhi(x2a.w);
            x2[8] = bflo(x2b.x); x2[9] = bfhi(x2b.x); x2[10] = bflo(x2b.y); x2[11] = bfhi(x2b.y); x2[12] = bflo(x2b.z); x2[13] = bfhi(x2b.z); x2[14] = bflo(x2b.w); x2[15] = bfhi(x2b.w);
#pragma unroll
            for (int q4 = 0; q4 < 4; ++q4) { const f32x4 cv = *(const f32x4*)(tcos + (size_t)tok * 32 + 16 * part + 4 * q4), sv = *(const f32x4*)(tsin + (size_t)tok * 32 + 16 * part + 4 * q4);
                cs[4 * q4] = cv.x; cs[4 * q4 + 1] = cv.y; cs[4 * q4 + 2] = cv.z; cs[4 * q4 + 3] = cv.w; sn[4 * q4] = sv.x; sn[4 * q4 + 1] = sv.y; sn[4 * q4 + 2] = sv.z; sn[4 * q4 + 3] = sv.w; }
            float o1[16], o2[16];
#pragma unroll
            for (int e = 0; e < 16; ++e) { o1[e] = x1[e] * cs[e] - x2[e] * sn[e]; o2[e] = x2[e] * cs[e] + x1[e] * sn[e]; }
            u32x4 wv;
            wv.x = cvt_pk_bf16(o1[0], o1[1]); wv.y = cvt_pk_bf16(o1[2], o1[3]); wv.z = cvt_pk_bf16(o1[4], o1[5]); wv.w = cvt_pk_bf16(o1[6], o1[7]); *(LAS u32x4*)(Ks + key * KS_LD + 16 * part) = wv;
            wv.x = cvt_pk_bf16(o1[8], o1[9]); wv.y = cvt_pk_bf16(o1[10], o1[11]); wv.z = cvt_pk_bf16(o1[12], o1[13]); wv.w = cvt_pk_bf16(o1[14], o1[15]); *(LAS u32x4*)(Ks + key * KS_LD + 16 * part + 8) = wv;
            wv.x = cvt_pk_bf16(o2[0], o2[1]); wv.y = cvt_pk_bf16(o2[2], o2[3]); wv.z = cvt_pk_bf16(o2[4], o2[5]); wv.w = cvt_pk_bf16(o2[6], o2[7]); *(LAS u32x4*)(Ks + key * KS_LD + 32 + 16 * part) = wv;
            wv.x = cvt_pk_bf16(o2[8], o2[9]); wv.y = cvt_pk_bf16(o2[10], o2[11]); wv.z = cvt_pk_bf16(o2[12], o2[13]); wv.w = cvt_pk_bf16(o2[14], o2[15]); *(LAS u32x4*)(Ks + key * KS_LD + 32 + 16 * part + 8) = wv;
            const bf16_t* vsrc = proj + (size_t)tok * D_IN + OFF_V + hk * 64 + 32 * part;
#pragma unroll
            for (int q4 = 0; q4 < 4; ++q4) { const u32x4 vv = *(const u32x4*)(vsrc + 8 * q4); LAS bf16_t* vd = Vt + (32 * part + 8 * q4) * VT_LD + key;
                vd[0 * VT_LD] = (bf16_t)(vv.x & 0xffffu); vd[1 * VT_LD] = (bf16_t)(vv.x >> 16); vd[2 * VT_LD] = (bf16_t)(vv.y & 0xffffu); vd[3 * VT_LD] = (bf16_t)(vv.y >> 16);
                vd[4 * VT_LD] = (bf16_t)(vv.z & 0xffffu); vd[5 * VT_LD] = (bf16_t)(vv.z >> 16); vd[6 * VT_LD] = (bf16_t)(vv.w & 0xffffu); vd[7 * VT_LD] = (bf16_t)(vv.w >> 16); }
        }
    }
    __syncthreads();
    const int hq = hk * 8 + w;
    const float sink2 = a.sinks[hq] * LOG2E;
    const float CS = 0.125f * LOG2E;
#pragma unroll 1
    for (int qq = 0; qq < 4; ++qq) {
        const int tokq = tok0 + 32 * qq + l32;
        const bf16_t* qsrc = proj + (size_t)tokq * D_IN + OFF_Q + hq * 64;
        bf16_t* osrc = (bf16_t*)(a.ws + WS_H) + (size_t)tokq * 2048 + hq * 64;
        bf16x8 qf[4];
        {
            u32x4 raw[4];
#pragma unroll
            for (int dd = 0; dd < 4; ++dd) raw[dd] = *(const u32x4*)(qsrc + 16 * dd + 8 * hi);
#pragma unroll
            for (int d2 = 0; d2 < 2; ++d2) {
                const float* cp = tcos + (size_t)tokq * 32 + 16 * d2 + 8 * hi; const float* sp = tsin + (size_t)tokq * 32 + 16 * d2 + 8 * hi;
                const f32x4 c0 = *(const f32x4*)cp, c1 = *(const f32x4*)(cp + 4), s0 = *(const f32x4*)sp, s1 = *(const f32x4*)(sp + 4);
                const float cs[8] = {c0.x, c0.y, c0.z, c0.w, c1.x, c1.y, c1.z, c1.w}, sn[8] = {s0.x, s0.y, s0.z, s0.w, s1.x, s1.y, s1.z, s1.w};
                const u32x4 r1 = raw[d2], r2 = raw[d2 + 2];
                const float x1[8] = {bflo(r1.x), bfhi(r1.x), bflo(r1.y), bfhi(r1.y), bflo(r1.z), bfhi(r1.z), bflo(r1.w), bfhi(r1.w)};
                const float x2[8] = {bflo(r2.x), bfhi(r2.x), bflo(r2.y), bfhi(r2.y), bflo(r2.z), bfhi(r2.z), bflo(r2.w), bfhi(r2.w)};
                float o1[8], o2[8];
#pragma unroll
                for (int e = 0; e < 8; ++e) { o1[e] = x1[e] * cs[e] - x2[e] * sn[e]; o2[e] = x2[e] * cs[e] + x1[e] * sn[e]; }
                u32x4 w1, w2;
                w1.x = cvt_pk_bf16(o1[0], o1[1]); w1.y = cvt_pk_bf16(o1[2], o1[3]); w1.z = cvt_pk_bf16(o1[4], o1[5]); w1.w = cvt_pk_bf16(o1[6], o1[7]);
                w2.x = cvt_pk_bf16(o2[0], o2[1]); w2.y = cvt_pk_bf16(o2[2], o2[3]); w2.z = cvt_pk_bf16(o2[4], o2[5]); w2.w = cvt_pk_bf16(o2[6], o2[7]);
                qf[d2] = __builtin_bit_cast(bf16x8, w1); qf[d2 + 2] = __builtin_bit_cast(bf16x8, w2);
            }
        }
        f32x16 s[5];
#pragma unroll
        for (int kbi = 0; kbi < 5; ++kbi) {
#pragma unroll
            for (int i = 0; i < 16; ++i) s[kbi][i] = 0.f;
            const LAS bf16_t* kp = Ks + (32 * (qq + kbi) + l32) * KS_LD + 8 * hi;
#pragma unroll
            for (int dd = 0; dd < 4; ++dd) { const bf16x8 kf = *(const LAS bf16x8*)(kp + 16 * dd); s[kbi] = __builtin_amdgcn_mfma_f32_32x32x16_bf16(kf, qf[dd], s[kbi], 0, 0, 0); }
        }
        if (nb == 0) {
#pragma unroll
            for (int kbi = 0; kbi < 4; ++kbi) if (qq + kbi < 4) {
#pragma unroll
                for (int i = 0; i < 16; ++i) s[kbi][i] = -1e30f; }
        }
        const int tq = l32 - 4 * hi;
#pragma unroll
        for (int i = 0; i < 16; ++i) { const int rr = 8 * (i >> 2) + (i & 3); s[0][i] = (rr > tq) ? s[0][i] : -1e30f; s[4][i] = (rr <= tq) ? s[4][i] : -1e30f; }
        float mx = -1e30f;
#pragma unroll
        for (int kbi = 0; kbi < 5; ++kbi)
#pragma unroll
            for (int i = 0; i < 16; i += 2) mx = fmaxf(mx, fmaxf(s[kbi][i], s[kbi][i + 1]));
        mx = fmaxf(mx, __shfl_xor(mx, 32)); mx = fmaxf(mx * CS, sink2);
        const float nmx = -mx;
        float lsum = 0.f;
        bf16x8 pk[5][2];
#pragma unroll
        for (int kbi = 0; kbi < 5; ++kbi) {
#pragma unroll
            for (int i = 0; i < 16; ++i) { const float p = __builtin_amdgcn_exp2f(fmaf(s[kbi][i], CS, nmx)); s[kbi][i] = p; lsum += p; }
#pragma unroll
            for (int j2 = 0; j2 < 2; ++j2) { u32x4 pw;
                pw.x = cvt_pk_bf16(s[kbi][8 * j2 + 0], s[kbi][8 * j2 + 1]); pw.y = cvt_pk_bf16(s[kbi][8 * j2 + 2], s[kbi][8 * j2 + 3]);
                pw.z = cvt_pk_bf16(s[kbi][8 * j2 + 4], s[kbi][8 * j2 + 5]); pw.w = cvt_pk_bf16(s[kbi][8 * j2 + 6], s[kbi][8 * j2 + 7]);
                pk[kbi][j2] = __builtin_bit_cast(bf16x8, pw); }
        }
        lsum += __shfl_xor(lsum, 32); lsum += __builtin_amdgcn_exp2f(sink2 - mx);
        const float inv = 1.0f / lsum;
        f32x16 o[2];
#pragma unroll
        for (int db = 0; db < 2; ++db)
#pragma unroll
            for (int i = 0; i < 16; ++i) o[db][i] = 0.f;
#pragma unroll
        for (int kbi = 0; kbi < 5; ++kbi)
#pragma unroll
            for (int j2 = 0; j2 < 2; ++j2)
#pragma unroll
                for (int db = 0; db < 2; ++db) {
                    const LAS bf16_t* vp = Vt + (32 * db + l32) * VT_LD + 32 * (qq + kbi) + 16 * j2 + 4 * hi;
                    const s16x4 lo = *(const LAS s16x4*)vp, hh = *(const LAS s16x4*)(vp + 8);
                    const bf16x8 vf = (bf16x8){lo[0], lo[1], lo[2], lo[3], hh[0], hh[1], hh[2], hh[3]};
                    o[db] = __builtin_amdgcn_mfma_f32_32x32x16_bf16(vf, pk[kbi][j2], o[db], 0, 0, 0);
                }
#pragma unroll
        for (int db = 0; db < 2; ++db)
#pragma unroll
            for (int g = 0; g < 4; ++g) { u32x2 wv; wv.x = cvt_pk_bf16(o[db][4 * g] * inv, o[db][4 * g + 1] * inv); wv.y = cvt_pk_bf16(o[db][4 * g + 2] * inv, o[db][4 * g + 3] * inv);
                *(u32x2*)(osrc + 32 * db + 8 * g + 4 * hi) = wv; }
    }
    __syncthreads();
}

__device__ __forceinline__ void grid_barrier(unsigned* ctr, unsigned target) {
    asm volatile("s_waitcnt vmcnt(0) lgkmcnt(0)" ::: "memory");
    __syncthreads();
    if (threadIdx.x == 0) {
        __builtin_amdgcn_fence(__ATOMIC_RELEASE, "agent");
        asm volatile("s_waitcnt vmcnt(0)" ::: "memory");
        __hip_atomic_fetch_add(ctr, 1u, __ATOMIC_RELAXED, __HIP_MEMORY_SCOPE_AGENT);
        while (__hip_atomic_load(ctr, __ATOMIC_RELAXED, __HIP_MEMORY_SCOPE_AGENT) < target) __builtin_amdgcn_s_sleep(2);
        __builtin_amdgcn_fence(__ATOMIC_ACQUIRE, "agent");
        asm volatile("s_waitcnt vmcnt(0)" ::: "memory");
    }
    __syncthreads();
}
#define GRID_SYNC() do { ++bar_k; grid_barrier(bar_ctr, bar_k * (unsigned)gridDim.x); } while (0)
__global__ void __launch_bounds__(512, 2) fwd_megakernel(Args a) {
    extern __shared__ __attribute__((aligned(16))) unsigned char lds_raw[];
    LAS unsigned char* lds = (LAS unsigned char*)lds_raw;
    cg::grid_group grid = cg::this_grid();
    const int tid = threadIdx.x, lane = tid & 63, wave = __builtin_amdgcn_readfirstlane(tid >> 6);
    const int G = gridDim.x, bx = blockIdx.x;
    const int gw = bx * 8 + wave, NGW = G * 8;
    bf16_t* proj = (bf16_t*)(a.ws + WS_P);
    bf16_t* Hb = (bf16_t*)(a.ws + WS_H);
    unsigned* bar_ctr = (unsigned*)(a.ws + WS_CTL); unsigned bar_k = 0;
    grid.sync();

    for (int rep_ = 0; rep_ < REP_A; ++rep_) {
    {
        LAS float* scr = (LAS float*)(lds + wave * 16384);
        constexpr int I_IN = (D_MODEL / 64) * (D_IN / 32), I_SQ = (2048 / 64) * (2048 / 32), I_UP = (D_MODEL / 64) * (D_FF / 32), I_DN = (D_FF / 64) * (D_MODEL / 32), I_RG = 8 * 32;
        constexpr int NITEMS = I_IN + 3 * I_SQ + I_UP + I_DN + 2 * I_RG;
        for (int it = gw; it < NITEMS; it += NGW) {
            int r = it;
            if (r < I_IN) { p0_transpose_item(a.w_in, D_MODEL, D_IN, (bf16_t*)(a.ws + WS_WIN), scr, r, lane); continue; } r -= I_IN;
            if (r < I_SQ) { p0_transpose_item(a.w_rnn, 2048, 2048, (bf16_t*)(a.ws + WS_WRNN), scr, r, lane); continue; } r -= I_SQ;
            if (r < I_SQ) { p0_transpose_item(a.w_attn, 2048, 2048, (bf16_t*)(a.ws + WS_WATT), scr, r, lane); continue; } r -= I_SQ;
            if (r < I_SQ) { p0_transpose_item(a.w_out, 2048, 2048, (bf16_t*)(a.ws + WS_WOUT), scr, r, lane); continue; } r -= I_SQ;
            if (r < I_UP) { p0_transpose_item(a.w_up, D_MODEL, D_FF, (bf16_t*)(a.ws + WS_WUP), scr, r, lane); continue; } r -= I_UP;
            if (r < I_DN) { p0_transpose_item(a.w_down, D_FF, D_MODEL, (bf16_t*)(a.ws + WS_WDN), scr, r, lane); continue; } r -= I_DN;
            if (r < I_RG) { const int nb = r >> 5; p0_transpose_item(a.w_rg_a + (size_t)nb * 65536, 256, 256, (bf16_t*)(a.ws + WS_WRGA) + (size_t)nb * 65536, scr, r & 31, lane); continue; } r -= I_RG;
            { const int nb = r >> 5; p0_transpose_item(a.w_rg_x + (size_t)nb * 65536, 256, 256, (bf16_t*)(a.ws + WS_WRGX) + (size_t)nb * 65536, scr, r & 31, lane); }
        }
        for (int m = gw; m < M_TOK; m += NGW) rms_row_to_bf16(a.x + (size_t)m * D_MODEL, a.g_pre, Hb + (size_t)m * D_MODEL, lane);
        float* tcos = (float*)(a.ws + WS_COS); float* tsin = (float*)(a.ws + WS_SIN);
        for (int i = bx * 512 + tid; i < M_TOK * 32; i += G * 512) {
            const int tok = i >> 5, f = i & 31;
            const float inv_freq = exp2f(-(float)f * (13.287712379549449f / 32.0f));
            const float ang = (float)a.pos[tok] * inv_freq;
            float sv, cv; sincosf(ang, &sv, &cv); tcos[i] = cv; tsin[i] = sv;
        }
    }
    GRID_SYNC();
    }
    for (int rep_ = 0; rep_ < REP_G; ++rep_) {
    {
        pg8::Gemm g{Hb, (const bf16_t*)(a.ws + WS_WIN), M_TOK, D_IN, D_MODEL, D_MODEL}; pg8::StaticOrder S; S.init(M_TOK, D_IN, G, bx);
        pg8::EpiBf16 E{proj, D_IN, 0};
        pg8::gemm_phase<pg8::EpiBf16>(lds, g, S, E);
    }
    GRID_SYNC();
    }
    for (int rep_ = 0; rep_ < REP_B; ++rep_) {
    for (int it = bx; it < 256 * 8; it += G) rnn_tile(a, lds, it >> 3, it & 7);
    GRID_SYNC();
    }
    for (int rep_ = 0; rep_ < REP_C; ++rep_) {
    {
        if (tid < 32) {
            const int gi = bx * 32 + tid;
            if (gi < BATCH * D_RNN) {
                const int b = gi / D_RNN, ch = gi % D_RNN;
                const float* sa = (const float*)(a.ws + WS_SUMA) + (size_t)b * 64 * D_RNN + ch; const float* sb = (const float*)(a.ws + WS_SUMB) + (size_t)b * 64 * D_RNN + ch;
                float* hin = (float*)(a.ws + WS_HIN) + (size_t)b * 64 * D_RNN + ch;
                float H = 0.f;
                for (int j0 = 0; j0 < 64; j0 += 8) {
                    float av[8], bv[8];
#pragma unroll
                    for (int j = 0; j < 8; ++j) { av[j] = sa[(size_t)(j0 + j) * D_RNN]; bv[j] = sb[(size_t)(j0 + j) * D_RNN]; }
#pragma unroll
                    for (int j = 0; j < 8; ++j) { hin[(size_t)(j0 + j) * D_RNN] = H; H = H * av[j] + bv[j]; }
                }
            }
        }
        for (int it = bx; it < 1024; it += G) attn_item(a, lds, it);
    }
    GRID_SYNC();
    }
    rnn_fixup(a, bx, G);
    GRID_SYNC();
    {
        pg8::StaticOrder S; S.init(M_TOK, D_MODEL, G, bx);
        { pg8::Gemm g{proj + OFF_YR, (const bf16_t*)(a.ws + WS_WRNN), M_TOK, D_MODEL, D_RNN, D_IN};
          pg8::EpiGate E{proj + OFF_GR, nullptr, D_IN}; pg8::gemm_phase<pg8::EpiGate>(lds, g, S, E); }
        { pg8::Gemm g{Hb, (const bf16_t*)(a.ws + WS_WATT), M_TOK, D_MODEL, 2048, 2048};
          pg8::EpiGate E{proj + OFF_GA, proj + OFF_GR, D_IN}; pg8::gemm_phase<pg8::EpiGate>(lds, g, S, E); }
    }
    GRID_SYNC();
    for (int rep_ = 0; rep_ < REP_G; ++rep_) {
    {
        pg8::Gemm g{proj + OFF_GA, (const bf16_t*)(a.ws + WS_WOUT), M_TOK, D_MODEL, D_MODEL, D_IN}; pg8::StaticOrder S; S.init(M_TOK, D_MODEL, G, bx);
        pg8::EpiBf16 E{proj + OFF_XR, D_IN, 4}; pg8::gemm_phase<pg8::EpiBf16>(lds, g, S, E);
    }
    GRID_SYNC();
    }
    for (int m = gw; m < M_TOK; m += NGW) {
        f32x4* tr = (f32x4*)(a.out + (size_t)m * D_MODEL) + lane; const f32x4* xr = (const f32x4*)(a.x + (size_t)m * D_MODEL) + lane;
        const u32x2* tb = (const u32x2*)(proj + (size_t)m * D_IN + OFF_XR) + lane;
        const f32x4* g1 = (const f32x4*)a.g_post + lane; const f32x4* g2 = (const f32x4*)a.g_mlp_pre + lane;
        f32x4 v[8]; float s = 0.f;
#pragma unroll
        for (int j = 0; j < 8; ++j) { const u32x2 t2 = tb[64 * j]; v[j] = (f32x4){bflo(t2.x), bfhi(t2.x), bflo(t2.y), bfhi(t2.y)}; s += (v[j].x * v[j].x + v[j].y * v[j].y) + (v[j].z * v[j].z + v[j].w * v[j].w); }
        const float rstd = 1.0f / sqrtf(wave_sum(s) * (1.f / D_MODEL) + RMS_EPS);
        float s2 = 0.f;
#pragma unroll
        for (int j = 0; j < 8; ++j) { const f32x4 xx = xr[64 * j], gg = g1[64 * j]; v[j] = xx + v[j] * rstd * gg; tr[64 * j] = v[j]; s2 += (v[j].x * v[j].x + v[j].y * v[j].y) + (v[j].z * v[j].z + v[j].w * v[j].w); }
        const float rstd2 = 1.0f / sqrtf(wave_sum(s2) * (1.f / D_MODEL) + RMS_EPS);
        u32x2* o8 = (u32x2*)(Hb + (size_t)m * D_MODEL) + lane;
#pragma unroll
        for (int j = 0; j < 8; ++j) { const f32x4 gg = g2[64 * j]; u32x2 w; w.x = cvt_pk_bf16(v[j].x * rstd2 * gg.x, v[j].y * rstd2 * gg.y); w.y = cvt_pk_bf16(v[j].z * rstd2 * gg.z, v[j].w * rstd2 * gg.w); o8[64 * j] = w; }
    }
    GRID_SYNC();
    for (int rep_ = 0; rep_ < REP_G; ++rep_) {
    {
        pg8::Gemm g{Hb, (const bf16_t*)(a.ws + WS_WUP), M_TOK, D_FF, D_MODEL, D_MODEL}; pg8::StaticOrder S; S.init(M_TOK, D_FF, G, bx);
        pg8::EpiBf16 E{(bf16_t*)(a.ws + WS_U), D_FF, 3}; pg8::gemm_phase<pg8::EpiBf16>(lds, g, S, E);
    }
    GRID_SYNC();
    }
    for (int rep_ = 0; rep_ < REP_G; ++rep_) {
    {
        pg8::Gemm g{(const bf16_t*)(a.ws + WS_U), (const bf16_t*)(a.ws + WS_WDN), M_TOK, D_MODEL, D_FF, D_FF}; pg8::StaticOrder S; S.init(M_TOK, D_MODEL, G, bx);
        pg8::EpiBf16 E{(bf16_t*)(a.ws + WS_D), D_MODEL, 4}; pg8::gemm_phase<pg8::EpiBf16>(lds, g, S, E);
    }
    GRID_SYNC();
    }
    for (int m = gw; m < M_TOK; m += NGW) {
        f32x4* orow = (f32x4*)(a.out + (size_t)m * D_MODEL) + lane; const u32x2* dr = (const u32x2*)((const bf16_t*)(a.ws + WS_D) + (size_t)m * D_MODEL) + lane;
        const f32x4* g1 = (const f32x4*)a.g_mlp_post + lane;
        f32x4 v[8]; float s = 0.f;
#pragma unroll
        for (int j = 0; j < 8; ++j) { const u32x2 t2 = dr[64 * j]; v[j] = (f32x4){bflo(t2.x), bfhi(t2.x), bflo(t2.y), bfhi(t2.y)}; s += (v[j].x * v[j].x + v[j].y * v[j].y) + (v[j].z * v[j].z + v[j].w * v[j].w); }
        const float rstd = 1.0f / sqrtf(wave_sum(s) * (1.f / D_MODEL) + RMS_EPS);
#pragma unroll
        for (int j = 0; j < 8; ++j) { const f32x4 gg = g1[64 * j]; orow[64 * j] = orow[64 * j] + v[j] * rstd * gg; }
    }
}

extern "C" void kernel_launch(void* const* d_in, const int* in_sizes, int n_in, void* d_out, int out_size, void* d_ws, size_t ws_size, hipStream_t stream) {
    static int grid_blocks = 0;
    if (grid_blocks == 0) {
        if (n_in != 20 || in_sizes[0] != M_TOK * D_MODEL || out_size != M_TOK * D_MODEL || ws_size < WS_END) {
            fprintf(stderr, "kernel_launch: unexpected shapes: n_in %d in0 %d out %d ws %zu (need %zu)\n", n_in, n_in > 0 ? in_sizes[0] : -1, out_size, ws_size, (size_t)WS_END); grid_blocks = -1; return; }
        int dev = 0, cus = 0, per_cu = 0;
        (void)hipGetDevice(&dev);
        (void)hipDeviceGetAttribute(&cus, hipDeviceAttributeMultiprocessorCount, dev);
        if (hipFuncSetAttribute((const void*)fwd_megakernel, hipFuncAttributeMaxDynamicSharedMemorySize, LDS_BYTES) != hipSuccess) fprintf(stderr, "kernel_launch: hipFuncSetAttribute failed\n");
        if (hipOccupancyMaxActiveBlocksPerMultiprocessor(&per_cu, (const void*)fwd_megakernel, 512, LDS_BYTES) != hipSuccess || per_cu < 1) { fprintf(stderr, "kernel_launch: occupancy query gave %d\n", per_cu); per_cu = 1; }
        (void)hipGetLastError();
        grid_blocks = cus * per_cu;
    }
    if (grid_blocks < 0) return;
    Args a{};
    a.x = (const float*)d_in[0]; a.pos = (const int*)d_in[1]; a.g_pre = (const float*)d_in[2]; a.w_in = (const float*)d_in[3]; a.conv_w = (const float*)d_in[4]; a.conv_b = (const float*)d_in[5];
    a.w_rg_a = (const float*)d_in[6]; a.b_rg_a = (const float*)d_in[7]; a.w_rg_x = (const float*)d_in[8]; a.b_rg_x = (const float*)d_in[9]; a.lam = (const float*)d_in[10]; a.sinks = (const float*)d_in[11];
    a.w_rnn = (const float*)d_in[12]; a.w_attn = (const float*)d_in[13]; a.w_out = (const float*)d_in[14]; a.g_post = (const float*)d_in[15]; a.g_mlp_pre = (const float*)d_in[16];
    a.w_up = (const float*)d_in[17]; a.w_down = (const float*)d_in[18]; a.g_mlp_post = (const float*)d_in[19];
    a.out = (float*)d_out; a.ws = (unsigned char*)d_ws;
    if (hipMemsetAsync((char*)d_ws + WS_CTL, 0, 256, stream) != hipSuccess) { fprintf(stderr, "kernel_launch: memset failed\n"); return; }
    void* args[] = {&a};
    hipError_t e = hipLaunchCooperativeKernel((const void*)fwd_megakernel, dim3(grid_blocks), dim3(512), args, LDS_BYTES, stream);
    if (e != hipSuccess) fprintf(stderr, "cooperative launch failed: %s (grid %d)\n", hipGetErrorString(e), grid_blocks);
}
```

```cpp
#include <hip/hip_runtime.h>
#include <hip/hip_cooperative_groups.h>
#include <cstdio>
#include <cstdint>
namespace cg = cooperative_groups;

#define LAS __attribute__((address_space(3)))
typedef unsigned short bf16_t;
typedef short bf16x8 __attribute__((ext_vector_type(8)));
typedef short s16x4 __attribute__((ext_vector_type(4)));
typedef float f32x4 __attribute__((ext_vector_type(4)));
typedef float f32x2 __attribute__((ext_vector_type(2)));
typedef float f32x16 __attribute__((ext_vector_type(16)));
typedef unsigned u32x4 __attribute__((ext_vector_type(4)));
typedef unsigned u32x2 __attribute__((ext_vector_type(2)));

constexpr int D_MODEL = 2048, BATCH = 4, SEQ = 8192, M_TOK = BATCH * SEQ;
constexpr int D_RNN = 2048, D_FF = 8192, D_IN = 10752;
constexpr int OFF_XR = 0, OFF_YR = 2048, OFF_Q = 4096, OFF_K = 6144, OFF_V = 6400, OFF_GR = 6656, OFF_GA = 8704;
constexpr float RMS_EPS = 1e-6f;
constexpr float LOG2E = 1.4426950408889634f;

constexpr size_t MiB = 1u << 20;
constexpr size_t WS_COS = 0, WS_SIN = 4 * MiB, WS_SUMA = 8 * MiB, WS_SUMB = 10 * MiB, WS_HIN = 12 * MiB;
constexpr size_t WS_WRGA = 14 * MiB, WS_WRGX = 15 * MiB, WS_WIN = 16 * MiB, WS_WRNN = 58 * MiB, WS_WATT = 66 * MiB, WS_WOUT = 74 * MiB;
constexpr size_t WS_WUP = 82 * MiB, WS_WDN = 114 * MiB, WS_P = 146 * MiB, WS_H = 818 * MiB, WS_U = 146 * MiB, WS_D = 818 * MiB, WS_X1 = 658 * MiB, WS_CTL = 946 * MiB, WS_END = 947 * MiB;

constexpr int LDS_BYTES = 147456;
#ifndef REP_G
#define REP_G 1
#endif
#ifndef REP_A
#define REP_A 1
#endif
#ifndef REP_B
#define REP_B 1
#endif
#ifndef REP_C
#define REP_C 1
#endif

typedef __bf16 bf16x2_t __attribute__((ext_vector_type(2)));
__device__ __forceinline__ unsigned cvt_pk_bf16(float lo, float hi) { const f32x2 v = {lo, hi}; const bf16x2_t b = __builtin_convertvector(v, bf16x2_t); return __builtin_bit_cast(unsigned, b); }
__device__ __forceinline__ float bf2f(unsigned short b) { return __uint_as_float(((unsigned)b) << 16); }
__device__ __forceinline__ float bflo(unsigned w) { return __uint_as_float(w << 16); }
__device__ __forceinline__ float bfhi(unsigned w) { return __uint_as_float(w & 0xffff0000u); }
__device__ __forceinline__ float sigmoidf_(float v) { return __builtin_amdgcn_rcpf(1.0f + __builtin_amdgcn_exp2f(-v * LOG2E)); }
__device__ __forceinline__ float gelu_tanh(float v) { const float u = 1.5957691216057308f * (v + 0.044715f * v * v * v); return v * sigmoidf_(u); }
__device__ __forceinline__ float wave_sum(float v) {
#pragma unroll
    for (int o = 1; o < 64; o <<= 1) v += __shfl_xor(v, o);
    return v;
}

namespace pg8 {
constexpr int BM = 256, BK = 64, HALF = 128, HTB = HALF * BK * 2, STAGE_BYTES = 8 * HTB, NXCD = 8, WGM = 8;
__host__ __device__ __forceinline__ int lds_byte(int r, int c) { const int st = (r >> 4) * 2 + (c >> 5), rr = r & 15, cc = c & 31, ob = rr * 64 + cc * 2; return st * 1024 + (ob ^ (((ob >> 9) & 1) << 5)); }
__host__ __device__ __forceinline__ void stage_rc(int b, int& R, int& C) { const int st = b / 1024, sb = b % 1024, swz = sb ^ (((sb >> 9) & 1) << 5); R = (st >> 1) * 16 + swz / 64; C = (st & 1) * 32 + (swz % 64) / 2; }
__host__ __device__ __forceinline__ int perm32(int rho) { const int n = rho >> 4, i = rho & 15; return 8 * (i >> 2) + 4 * n + (i & 3); }

struct Unit { int pm, pn; };
struct Gemm { const bf16_t* A; const bf16_t* Bt; int M, N, K, lda; };

struct StaticOrder {
    int nM, nN, nwg, G, c;
    __device__ void init(int M, int N, int G_, int c_) { nM = M / BM; nN = N / BM; nwg = nM * nN; G = G_; c = c_; }
    __device__ bool next(int i, Unit& u) const {
        const long L = (long)i * G + c; if (L >= nwg) return false;
        int wgid = (int)L; { const int q = nwg / NXCD, r = nwg % NXCD, xcd = wgid % NXCD, off = wgid / NXCD; wgid = (xcd < r ? xcd * (q + 1) : r * (q + 1) + (xcd - r) * q) + off; }
        const int nig = WGM * nN, gid = wgid / nig, fm = gid * WGM, gsz = (nM - fm) < WGM ? (nM - fm) : WGM;
        u.pm = fm + ((wgid % nig) % gsz); u.pn = (wgid % nig) / gsz; return true;
    }
};

struct EpiBf16 {
    static constexpr bool PERM = true;
    bf16_t* O; int ldc; int mode;
    template <int ACT> __device__ __forceinline__ void run(const f32x4 (&acc)[2][2][4][2], const Unit& u, int wr, int wc, int fr, int fq) const {
        const int row0 = u.pm * BM + wr * 64 + fr, col0 = u.pn * BM + wc * 32 + 8 * fq;
#pragma unroll
        for (int ai = 0; ai < 2; ++ai)
#pragma unroll
            for (int m = 0; m < 4; ++m) { bf16_t* rowp = O + (size_t)(row0 + ai * HALF + m * 16) * ldc + col0;
#pragma unroll
                for (int bj = 0; bj < 2; ++bj) { f32x4 v0 = acc[ai][bj][m][0], v1 = acc[ai][bj][m][1];
#pragma unroll
                    for (int e = 0; e < 4; ++e) {
                        if (ACT == 1) { v0[e] = gelu_tanh(v0[e]); v1[e] = gelu_tanh(v1[e]); }
                        if (ACT == 2) { v0[e] = sigmoidf_(v0[e]); v1[e] = sigmoidf_(v1[e]); }
                        if (ACT == 3) { const float a0 = fmaxf(v0[e], 0.f), a1 = fmaxf(v1[e], 0.f); v0[e] = a0 * a0; v1[e] = a1 * a1; }
                    }
                    u32x4 w; w.x = cvt_pk_bf16(v0[0], v0[1]); w.y = cvt_pk_bf16(v0[2], v0[3]); w.z = cvt_pk_bf16(v1[0], v1[1]); w.w = cvt_pk_bf16(v1[2], v1[3]);
                    *(u32x4*)(rowp + bj * HALF) = w; } }
    }
    __device__ __forceinline__ void operator()(const f32x4 (&acc)[2][2][4][2], const Unit& u, int wr, int wc, int fr, int fq) const {
        if (mode == 3) { run<3>(acc, u, wr, wc, fr, fq); return; }
        if (mode == 4) { run<0>(acc, u, wr, wc, fr, fq); return; }
        const int seg = u.pn;
        if (seg >= 8 && seg < 16) run<1>(acc, u, wr, wc, fr, fq);
        else if (seg >= 26) run<2>(acc, u, wr, wc, fr, fq);
        else run<0>(acc, u, wr, wc, fr, fq);
    }
};
struct EpiGate {
    static constexpr bool PERM = true;
    bf16_t* G; const bf16_t* P; int ld;
    __device__ __forceinline__ void operator()(const f32x4 (&acc)[2][2][4][2], const Unit& u, int wr, int wc, int fr, int fq) const {
        const int row0 = u.pm * BM + wr * 64 + fr, col0 = u.pn * BM + wc * 32 + 8 * fq;
#pragma unroll
        for (int ai = 0; ai < 2; ++ai)
#pragma unroll
            for (int m = 0; m < 4; ++m) { const size_t ro = (size_t)(row0 + ai * HALF + m * 16) * ld + col0;
#pragma unroll
                for (int bj = 0; bj < 2; ++bj) { const f32x4 v0 = acc[ai][bj][m][0], v1 = acc[ai][bj][m][1];
                    const u32x4 g = *(const u32x4*)(G + ro + bj * HALF);
                    float o[8];
                    o[0] = bflo(g.x) * v0[0]; o[1] = bfhi(g.x) * v0[1]; o[2] = bflo(g.y) * v0[2]; o[3] = bfhi(g.y) * v0[3];
                    o[4] = bflo(g.z) * v1[0]; o[5] = bfhi(g.z) * v1[1]; o[6] = bflo(g.w) * v1[2]; o[7] = bfhi(g.w) * v1[3];
                    if (P) { const u32x4 p = *(const u32x4*)(P + ro + bj * HALF);
                        o[0] += bflo(p.x); o[1] += bfhi(p.x); o[2] += bflo(p.y); o[3] += bfhi(p.y); o[4] += bflo(p.z); o[5] += bfhi(p.z); o[6] += bflo(p.w); o[7] += bfhi(p.w); }
                    u32x4 w; w.x = cvt_pk_bf16(o[0], o[1]); w.y = cvt_pk_bf16(o[2], o[3]); w.z = cvt_pk_bf16(o[4], o[5]); w.w = cvt_pk_bf16(o[6], o[7]);
                    *(u32x4*)(G + ro + bj * HALF) = w; } }
    }
};
struct EpiF32 {
    static constexpr bool PERM = false;
    float* O; int ldc;
    __device__ __forceinline__ void operator()(const f32x4 (&acc)[2][2][4][2], const Unit& u, int wr, int wc, int fr, int fq) const {
        const int row0 = u.pm * BM + wr * 64 + fr, col0 = u.pn * BM + wc * 32 + 4 * fq;
#pragma unroll
        for (int ai = 0; ai < 2; ++ai)
#pragma unroll
            for (int m = 0; m < 4; ++m) { float* rowp = O + (size_t)(row0 + ai * HALF + m * 16) * ldc + col0;
#pragma unroll
                for (int bj = 0; bj < 2; ++bj)
#pragma unroll
                    for (int n = 0; n < 2; ++n) *(f32x4*)(rowp + bj * HALF + n * 16) = acc[ai][bj][m][n]; }
    }
};

template <class Epi>
__device__ __forceinline__ void gemm_phase(LAS unsigned char* lds, const Gemm g, const StaticOrder& S, const Epi& E) {
    int tid_ = threadIdx.x; asm volatile("" : "+v"(tid_));
    const int tid = tid_, wid = __builtin_amdgcn_readfirstlane(tid >> 6), lane = tid & 63, wr = wid >> 2, wc = wid & 3, fr = lane & 15, fq = lane >> 4;
    const int K = g.K, nt = K / BK, lda = g.lda;
    unsigned voffA[2], voffB[2];
#pragma unroll
    for (int i = 0; i < 2; ++i) { int R, C; stage_rc(tid * 16 + i * 8192, R, C); const int Rb = Epi::PERM ? ((R & ~31) + perm32(R & 31)) : R;
        voffA[i] = (unsigned)(R * lda + C) * 2u; voffB[i] = (unsigned)(Rb * K + C) * 2u; }
    const size_t kstep = (size_t)(BK * 2);
    const size_t hstepA = (size_t)HALF * lda * 2, hstepB = (size_t)HALF * K * 2;
    const size_t tstepA = 2 * hstepA, tstepB = 2 * hstepB;
    const unsigned ldsw = (unsigned)wid * 1024u;
    const int aoff = lds_byte(wr * 64 + fr, fq * 8), boff = lds_byte(wc * 32 + fr, fq * 8);
#define PG8_SA(b, h) (((b) * 2 + (h)) * HTB)
#define PG8_SB(b, h) ((4 + (b) * 2 + (h)) * HTB)
#define PG8_STAGE(bufoff, gbase, voff) do { _Pragma("unroll") for (int _i = 0; _i < 2; ++_i) \
        __builtin_amdgcn_global_load_lds((const unsigned*)((const char*)(gbase) + (voff)[_i]), (LAS unsigned*)(lds + (bufoff) + ldsw + _i * 8192), 16, 0, 0); } while (0)
#define PG8_LDA(dst, b, h) do { _Pragma("unroll") for (int m = 0; m < 4; ++m) _Pragma("unroll") for (int k = 0; k < 2; ++k) dst[m][k] = *(const LAS bf16x8*)(lds + PG8_SA(b, h) + aoff + m * 2048 + k * 1024); } while (0)
#define PG8_LDB(dst, b, h) do { _Pragma("unroll") for (int n = 0; n < 2; ++n) _Pragma("unroll") for (int k = 0; k < 2; ++k) dst[n][k] = *(const LAS bf16x8*)(lds + PG8_SB(b, h) + boff + n * 2048 + k * 1024); } while (0)
#define PG8_MMA(ai, bj, At, Bt) do { __builtin_amdgcn_s_setprio(1); _Pragma("unroll") for (int m = 0; m < 4; ++m) _Pragma("unroll") for (int n = 0; n < 2; ++n) _Pragma("unroll") for (int k = 0; k < 2; ++k) \
        acc[ai][bj][m][n] = __builtin_amdgcn_mfma_f32_16x16x32_bf16(Bt[n][k], At[m][k], acc[ai][bj][m][n], 0, 0, 0); __builtin_amdgcn_s_setprio(0); } while (0)
#define PG8_WAIT_V(n) asm volatile("s_waitcnt vmcnt(" #n ")" ::: "memory")
#define PG8_WAIT_L(n) asm volatile("s_waitcnt lgkmcnt(" #n ")" ::: "memory")
#define PG8_BAR __builtin_amdgcn_s_barrier()
#define PG8_SCHED __builtin_amdgcn_sched_barrier(0)
    Unit cur, nxt; int ui = 0;
    if (!S.next(0, cur)) return;
    f32x4 acc[2][2][4][2];
#pragma unroll
    for (int a = 0; a < 2; ++a)
#pragma unroll
        for (int b = 0; b < 2; ++b)
#pragma unroll
            for (int m = 0; m < 4; ++m)
#pragma unroll
                for (int n = 0; n < 2; ++n) acc[a][b][m][n] = (f32x4){0.f, 0.f, 0.f, 0.f};
    bf16x8 At[4][2], B0[2][2], B1[2][2];
    const char* cA = (const char*)g.A + (size_t)cur.pm * tstepA; const char* cB = (const char*)g.Bt + (size_t)cur.pn * tstepB;
    PG8_STAGE(PG8_SB(0, 0), cB, voffB); PG8_STAGE(PG8_SB(0, 1), cB + hstepB, voffB); PG8_STAGE(PG8_SA(0, 0), cA, voffA); PG8_STAGE(PG8_SA(0, 1), cA + hstepA, voffA);
    if (wr == 1) PG8_BAR;
    PG8_WAIT_V(2); PG8_BAR;
    PG8_STAGE(PG8_SB(1, 0), cB + kstep, voffB); PG8_STAGE(PG8_SA(1, 0), cA + kstep, voffA); PG8_STAGE(PG8_SB(1, 1), cB + hstepB + kstep, voffB);
    PG8_WAIT_V(6); PG8_BAR;
    for (;;) {
        const bool has_next = S.next(ui + 1, nxt);
        const char* nA = has_next ? (const char*)g.A + (size_t)nxt.pm * tstepA : cA; const char* nB = has_next ? (const char*)g.Bt + (size_t)nxt.pn * tstepB : cB;
        for (int t = 0; t < nt; t += 2) {
            const bool last = (t == nt - 2);
            const char* a1 = cA + (size_t)(t + 1) * kstep;
            const char* a2 = last ? nA : cA + (size_t)(t + 2) * kstep; const char* b2 = last ? nB : cB + (size_t)(t + 2) * kstep;
            const char* a3 = a2 + kstep; const char* b3 = b2 + kstep;
            PG8_STAGE(PG8_SA(1, 1), a1 + hstepA, voffA); PG8_SCHED; PG8_LDB(B0, 0, 0); PG8_LDB(B1, 0, 1); PG8_SCHED; PG8_LDA(At, 0, 0);
            PG8_WAIT_V(8); PG8_WAIT_L(0); PG8_BAR; PG8_MMA(0, 0, At, B0); PG8_MMA(0, 1, At, B1); PG8_BAR; PG8_SCHED;
            PG8_STAGE(PG8_SB(0, 0), b2, voffB); PG8_STAGE(PG8_SB(0, 1), b2 + hstepB, voffB); PG8_STAGE(PG8_SA(0, 0), a2, voffA); PG8_SCHED; PG8_LDA(At, 0, 1);
            PG8_WAIT_V(8); PG8_WAIT_L(0); PG8_BAR; PG8_MMA(1, 0, At, B0); PG8_MMA(1, 1, At, B1); PG8_BAR; PG8_SCHED;
            PG8_STAGE(PG8_SA(0, 1), a2 + hstepA, voffA); PG8_SCHED; PG8_LDB(B0, 1, 0); PG8_LDB(B1, 1, 1); PG8_SCHED; PG8_LDA(At, 1, 0);
            PG8_WAIT_V(8); PG8_WAIT_L(0); PG8_BAR; PG8_MMA(0, 0, At, B0); PG8_MMA(0, 1, At, B1); PG8_BAR; PG8_SCHED;
            PG8_STAGE(PG8_SB(1, 0), b3, voffB); PG8_STAGE(PG8_SB(1, 1), b3 + hstepB, voffB); PG8_STAGE(PG8_SA(1, 0), a3, voffA); PG8_SCHED; PG8_LDA(At, 1, 1);
            PG8_WAIT_V(8); PG8_WAIT_L(0); PG8_BAR; PG8_MMA(1, 0, At, B0); PG8_MMA(1, 1, At, B1); PG8_BAR; PG8_SCHED;
        }
        if (wr == 0) PG8_BAR;
        E(acc, cur, wr, wc, fr, fq);
        if (!has_next) break;
#pragma unroll
        for (int a = 0; a < 2; ++a)
#pragma unroll
            for (int b = 0; b < 2; ++b)
#pragma unroll
                for (int m = 0; m < 4; ++m)
#pragma unroll
                    for (int n = 0; n < 2; ++n) acc[a][b][m][n] = (f32x4){0.f, 0.f, 0.f, 0.f};
        cur = nxt; cA = nA; cB = nB; ++ui;
        if (wr == 1) PG8_BAR;
    }
    PG8_WAIT_V(0);
    PG8_BAR;
#undef PG8_SA
#undef PG8_SB
#undef PG8_STAGE
#undef PG8_LDA
#undef PG8_LDB
#undef PG8_MMA
#undef PG8_WAIT_V
#undef PG8_WAIT_L
#undef PG8_BAR
#undef PG8_SCHED
}
}

struct Args {
    const float* x; const int* pos; const float* g_pre; const float* w_in; const float* conv_w; const float* conv_b;
    const float* w_rg_a; const float* b_rg_a; const float* w_rg_x; const float* b_rg_x; const float* lam; const float* sinks;
    const float* w_rnn; const float* w_attn; const float* w_out; const float* g_post; const float* g_mlp_pre;
    const float* w_up; const float* w_down; const float* g_mlp_post;
    float* out; unsigned char* ws;
};

__device__ __forceinline__ void p0_transpose_item(const float* W, int K, int N, bf16_t* WT, LAS float* scr, int item, int lane, float scale = 1.0f) {
    const int nblk = N / 32, kb = item / nblk, nb = item % nblk, k0 = 64 * kb, n0 = 32 * nb;
    float tv[32];
#pragma unroll
    for (int i = 0; i < 32; ++i) tv[i] = W[(size_t)(k0 + 2 * i + (lane >> 5)) * N + n0 + (lane & 31)];
#pragma unroll
    for (int i = 0; i < 32; ++i) scr[(2 * i + (lane >> 5)) * 33 + (lane & 31)] = tv[i] * scale;
    asm volatile("s_waitcnt lgkmcnt(0)" ::: "memory");
    const int c = lane & 7;
#pragma unroll
    for (int j = 0; j < 4; ++j) { const int n = (lane >> 3) + 8 * j; const LAS float* s = scr + (8 * c) * 33 + n;
        u32x4 o; o.x = cvt_pk_bf16(s[0 * 33], s[1 * 33]); o.y = cvt_pk_bf16(s[2 * 33], s[3 * 33]); o.z = cvt_pk_bf16(s[4 * 33], s[5 * 33]); o.w = cvt_pk_bf16(s[6 * 33], s[7 * 33]);
        *(u32x4*)(WT + (size_t)(n0 + n) * K + k0 + 8 * c) = o; }
    asm volatile("s_waitcnt lgkmcnt(0)" ::: "memory");
}

__device__ __forceinline__ void rms_row_to_bf16(const float* xrow, const float* g, bf16_t* orow, int lane) {
    const f32x4* xr = (const f32x4*)xrow + lane; const f32x4* gr = (const f32x4*)g + lane;
    f32x4 v[8]; float s = 0.f;
#pragma unroll
    for (int j = 0; j < 8; ++j) { v[j] = xr[64 * j]; s += (v[j].x * v[j].x + v[j].y * v[j].y) + (v[j].z * v[j].z + v[j].w * v[j].w); }
    const float rstd = 1.0f / sqrtf(wave_sum(s) * (1.f / D_MODEL) + RMS_EPS);
    u32x2* o8 = (u32x2*)orow + lane;
#pragma unroll
    for (int j = 0; j < 8; ++j) { const f32x4 gg = gr[64 * j]; u32x2 w; w.x = cvt_pk_bf16(v[j].x * rstd * gg.x, v[j].y * rstd * gg.y); w.y = cvt_pk_bf16(v[j].z * rstd * gg.z, v[j].w * rstd * gg.w); o8[64 * j] = w; }
}

constexpr int XC_LD = 264;
constexpr int XC_BYTES = 128 * XC_LD * 2;
__device__ __forceinline__ void rnn_tile(const Args& a, LAS unsigned char* lds, int tile, int nblk) {
    int tid_ = threadIdx.x; asm volatile("" : "+v"(tid_));
    const int tid = tid_, lane = tid & 63, w = __builtin_amdgcn_readfirstlane(tid >> 6), hi = lane >> 5, l32 = lane & 31;
    bf16_t* proj = (bf16_t*)(a.ws + WS_P);
    bf16_t* qbuf = (bf16_t*)a.out;
    LAS bf16_t* xc = (LAS bf16_t*)lds;
    LAS bf16_t* yg = (LAS bf16_t*)(lds + XC_BYTES);
    LAS unsigned* rmask = (LAS unsigned*)(lds + 2 * XC_BYTES);
    const int tok0 = tile * 128, sidx0 = (tile & 63) * 128;
#pragma unroll
    for (int i = 0; i < 8; ++i) { const int p = tid + 512 * i, row = p >> 5, c16 = p & 31;
        *(LAS u32x4*)(yg + row * XC_LD + c16 * 8) = *(const u32x4*)(proj + (size_t)(tok0 + row) * D_IN + OFF_YR + nblk * 256 + c16 * 8); }
    {
        const int cgp = tid & 31, ts = tid >> 5, ch = nblk * 256 + cgp * 8;
        float wk[4][8], bb[8];
#pragma unroll
        for (int k = 0; k < 4; ++k) { const f32x4 w0 = *(const f32x4*)(a.conv_w + k * D_RNN + ch), w1 = *(const f32x4*)(a.conv_w + k * D_RNN + ch + 4);
            wk[k][0] = w0.x; wk[k][1] = w0.y; wk[k][2] = w0.z; wk[k][3] = w0.w; wk[k][4] = w1.x; wk[k][5] = w1.y; wk[k][6] = w1.z; wk[k][7] = w1.w; }
        { const f32x4 b0 = *(const f32x4*)(a.conv_b + ch), b1 = *(const f32x4*)(a.conv_b + ch + 4); bb[0] = b0.x; bb[1] = b0.y; bb[2] = b0.z; bb[3] = b0.w; bb[4] = b1.x; bb[5] = b1.y; bb[6] = b1.z; bb[7] = b1.w; }
        u32x4 raw[11];
#pragma unroll
        for (int j = 0; j < 11; ++j) { const int tl = ts * 8 + j - 3;
            if (sidx0 + tl >= 0) raw[j] = *(const u32x4*)(proj + (size_t)(tok0 + tl) * D_IN + OFF_XR + ch); else raw[j] = (u32x4){0u, 0u, 0u, 0u}; }
#pragma unroll
        for (int j = 0; j < 8; ++j) { float y[8];
#pragma unroll
            for (int e = 0; e < 8; ++e) y[e] = bb[e];
#pragma unroll
            for (int k = 0; k < 4; ++k) { const u32x4 r = raw[j + k];
                y[0] += wk[k][0] * bflo(r.x); y[1] += wk[k][1] * bfhi(r.x); y[2] += wk[k][2] * bflo(r.y); y[3] += wk[k][3] * bfhi(r.y);
                y[4] += wk[k][4] * bflo(r.z); y[5] += wk[k][5] * bfhi(r.z); y[6] += wk[k][6] * bflo(r.w); y[7] += wk[k][7] * bfhi(r.w); }
            u32x4 o; o.x = cvt_pk_bf16(y[0], y[1]); o.y = cvt_pk_bf16(y[2], y[3]); o.z = cvt_pk_bf16(y[4], y[5]); o.w = cvt_pk_bf16(y[6], y[7]);
            *(LAS u32x4*)(xc + (ts * 8 + j) * XC_LD + cgp * 8) = o; }
        if (tid < 128) { const bool z = (a.pos[tok0 + tid] == 0); const unsigned long long bal = __ballot(z); if (lane == 0) { rmask[2 * w] = (unsigned)bal; rmask[2 * w + 1] = (unsigned)(bal >> 32); } }
    }
    __syncthreads();
    const int cl = w * 32 + l32, c = nblk * 256 + cl;
    const bf16_t* wa = (const bf16_t*)(a.ws + WS_WRGA) + ((size_t)((nblk * 8 + w) * 16) * 64 + lane) * 8;
    const bf16_t* wx = (const bf16_t*)(a.ws + WS_WRGX) + ((size_t)((nblk * 8 + w) * 16) * 64 + lane) * 8;
    const float bav = -LOG2E * a.b_rg_a[c], bxv = -LOG2E * a.b_rg_x[c];
    f32x16 ga[4], gx[4];
#pragma unroll
    for (int mb = 0; mb < 4; ++mb)
#pragma unroll
        for (int i = 0; i < 16; ++i) { ga[mb][i] = bav; gx[mb][i] = bxv; }
    bf16x8 fa[4], fx[4];
#pragma unroll
    for (int p = 0; p < 3; ++p) { fa[p] = *(const bf16x8*)(wa + 512 * p); fx[p] = *(const bf16x8*)(wx + 512 * p); }
#pragma unroll
    for (int kk = 0; kk < 16; ++kk) {
        if (kk + 3 < 16) { fa[(kk + 3) & 3] = *(const bf16x8*)(wa + 512 * (kk + 3)); fx[(kk + 3) & 3] = *(const bf16x8*)(wx + 512 * (kk + 3)); }
#pragma unroll
        for (int mb = 0; mb < 4; ++mb) {
            const bf16x8 af = *(const LAS bf16x8*)(xc + (32 * mb + l32) * XC_LD + 16 * kk + 8 * hi);
            ga[mb] = __builtin_amdgcn_mfma_f32_32x32x16_bf16(af, fa[kk & 3], ga[mb], 0, 0, 0);
            gx[mb] = __builtin_amdgcn_mfma_f32_32x32x16_bf16(af, fx[kk & 3], gx[mb], 0, 0, 0);
        }
    }
    const float nsp = -8.0f * LOG2E * log1pf(expf(-a.lam[c]));
    float H = 0.f, C = 1.f;
#pragma unroll
    for (int mb = 0; mb < 4; ++mb) {
        const unsigned mw = (unsigned)__builtin_amdgcn_readfirstlane((int)rmask[mb]);
        float av[16], bv[16];
#pragma unroll
        for (int i = 0; i < 16; ++i) {
            const int row = 8 * (i >> 2) + 4 * hi + (i & 3);
            const float r = __builtin_amdgcn_rcpf(1.0f + __builtin_amdgcn_exp2f(ga[mb][i])), ig = __builtin_amdgcn_rcpf(1.0f + __builtin_amdgcn_exp2f(gx[mb][i]));
            const float aa = __builtin_amdgcn_exp2f(nsp * r);
            const float mult = __builtin_amdgcn_sqrtf(fmaf(-aa, aa, 1.0f));
            const float xv = bf2f(xc[(32 * mb + row) * XC_LD + cl]);
            av[i] = aa; bv[i] = mult * ig * xv;
        }
        if (mw != 0u) {
#pragma unroll
            for (int i = 0; i < 16; ++i) { const int row = 8 * (i >> 2) + 4 * hi + (i & 3);
                if ((mw >> row) & 1u) { const float ig = __builtin_amdgcn_rcpf(1.0f + __builtin_amdgcn_exp2f(gx[mb][i])); av[i] = 0.f; bv[i] = ig * bf2f(xc[(32 * mb + row) * XC_LD + cl]); } }
        }
#pragma unroll
        for (int g = 0; g < 4; ++g) {
            const float As = (av[4 * g] * av[4 * g + 1]) * (av[4 * g + 2] * av[4 * g + 3]);
            const float Bs = ((bv[4 * g] * av[4 * g + 1] + bv[4 * g + 1]) * av[4 * g + 2] + bv[4 * g + 2]) * av[4 * g + 3] + bv[4 * g + 3];
            const float Ao = __shfl_xor(As, 32), Bo = __shfl_xor(Bs, 32);
            const float Alo = hi ? Ao : As, Blo = hi ? Bo : Bs, Ahi = hi ? As : Ao, Bhi = hi ? Bs : Bo;
            float hs = hi ? (H * Alo + Blo) : H, cs = hi ? (C * Alo) : C;
#pragma unroll
            for (int j = 0; j < 4; ++j) { hs = av[4 * g + j] * hs + bv[4 * g + j]; cs *= av[4 * g + j];
                const int li = (32 * mb + 8 * g + 4 * hi + j) * XC_LD + cl;
                const float gy = bf2f(yg[li]);
                xc[li] = (bf16_t)(cvt_pk_bf16(hs * gy, 0.f) & 0xffffu); yg[li] = (bf16_t)(cvt_pk_bf16(cs * gy, 0.f) & 0xffffu); }
            H = (H * Alo + Blo) * Ahi + Bhi; C *= Alo * Ahi;
        }
    }
    if (hi == 0) { ((float*)(a.ws + WS_SUMA))[(size_t)tile * D_RNN + c] = C; ((float*)(a.ws + WS_SUMB))[(size_t)tile * D_RNN + c] = H; }
    __syncthreads();
#pragma unroll
    for (int i = 0; i < 8; ++i) { const int p = tid + 512 * i, row = p >> 5, c16 = p & 31;
        *(u32x4*)(proj + (size_t)(tok0 + row) * D_IN + OFF_YR + nblk * 256 + c16 * 8) = *(const LAS u32x4*)(xc + row * XC_LD + c16 * 8);
        *(u32x4*)(qbuf + (size_t)(tok0 + row) * D_RNN + nblk * 256 + c16 * 8) = *(const LAS u32x4*)(yg + row * XC_LD + c16 * 8); }
    __syncthreads();
}
__device__ __forceinline__ void rnn_fixup(const Args& a, int bx, int G) {
    bf16_t* proj = (bf16_t*)(a.ws + WS_P); const bf16_t* qbuf = (const bf16_t*)a.out; const float* hin = (const float*)(a.ws + WS_HIN);
    int tid_ = threadIdx.x; asm volatile("" : "+v"(tid_));
    for (int idx = bx * 512 + tid_; idx < M_TOK * 256; idx += G * 512) {
        const int row = idx >> 8, c8 = (idx & 255) * 8, tile = row >> 7;
        bf16_t* pp = proj + (size_t)row * D_IN + OFF_YR + c8;
        const u32x4 p = *(const u32x4*)pp, q = *(const u32x4*)(qbuf + (size_t)row * D_RNN + c8);
        const f32x4 h0 = *(const f32x4*)(hin + (size_t)tile * D_RNN + c8), h1 = *(const f32x4*)(hin + (size_t)tile * D_RNN + c8 + 4);
        u32x4 o;
        o.x = cvt_pk_bf16(bflo(p.x) + bflo(q.x) * h0.x, bfhi(p.x) + bfhi(q.x) * h0.y); o.y = cvt_pk_bf16(bflo(p.y) + bflo(q.y) * h0.z, bfhi(p.y) + bfhi(q.y) * h0.w);
        o.z = cvt_pk_bf16(bflo(p.z) + bflo(q.z) * h1.x, bfhi(p.z) + bfhi(q.z) * h1.y); o.w = cvt_pk_bf16(bflo(p.w) + bflo(q.w) * h1.z, bfhi(p.w) + bfhi(q.w) * h1.w);
        *(u32x4*)pp = o;
    }
}

constexpr int KS_LD = 72, VT_LD = 264, VT_OFF = 256 * KS_LD * 2;
constexpr int TAB_LDB = 144, TC_OFF = VT_OFF + 64 * VT_LD * 2, TS_OFF = TC_OFF + 128 * TAB_LDB, ST_OFF = TS_OFF + 128 * TAB_LDB, ST_LDB = 144, ST_WAVE = 32 * ST_LDB;
static_assert(ST_OFF + 8 * ST_WAVE <= LDS_BYTES, "attention LDS map");
__device__ __forceinline__ void attn_item(const Args& a, LAS unsigned char* lds, int item) {
    int tid_ = threadIdx.x; asm volatile("" : "+v"(tid_));
    const int tid = tid_, lane = tid & 63, w = __builtin_amdgcn_readfirstlane(tid >> 6), hi = lane >> 5, l32 = lane & 31;
    const int b = item >> 8, nb = (item >> 2) & 63, hk = item & 3;
    bf16_t* proj = (bf16_t*)(a.ws + WS_P);
    const float* tcos = (const float*)(a.ws + WS_COS); const float* tsin = (const float*)(a.ws + WS_SIN);
    LAS bf16_t* Ks = (LAS bf16_t*)lds; LAS bf16_t* Vt = (LAS bf16_t*)(lds + VT_OFF);
    const int tok0 = b * SEQ + nb * 128;
    const int hq = hk * 8 + w;
    const float sink2 = a.sinks[hq] * LOG2E;
    const float CS = 0.125f * LOG2E;
    u32x4 qraw[4];
    LAS unsigned char* stage = lds + ST_OFF + w * ST_WAVE;
    const int st_rw = ((lane >> 3) * ST_LDB) + (lane & 7) * 16;
#define ATT_LOADQ(QQ) do { const bf16_t* qp_ = proj + (size_t)(tok0 + 32 * (QQ) + (lane >> 3)) * D_IN + OFF_Q + hq * 64 + 8 * (lane & 7); \
        _Pragma("unroll") for (int it = 0; it < 4; ++it) qraw[it] = *(const u32x4*)(qp_ + (size_t)(8 * it) * D_IN); } while (0)
    ATT_LOADQ(0);
    {
        const int key = tid >> 1, part = tid & 1;
        if (nb == 0 && key < 128) {
            const u32x4 z = (u32x4){0u, 0u, 0u, 0u};
            *(LAS u32x4*)(Ks + key * KS_LD + 16 * part) = z; *(LAS u32x4*)(Ks + key * KS_LD + 16 * part + 8) = z;
            *(LAS u32x4*)(Ks + key * KS_LD + 32 + 16 * part) = z; *(LAS u32x4*)(Ks + key * KS_LD + 32 + 16 * part + 8) = z;
#pragma unroll
            for (int e = 0; e < 32; ++e) Vt[(32 * part + e) * VT_LD + key] = 0;
        } else {
            const int tok = tok0 - 128 + key;
            const bf16_t* ksrc = proj + (size_t)tok * D_IN + OFF_K + hk * 64 + 16 * part;
            const u32x4 x1a = *(const u32x4*)(ksrc), x1b = *(const u32x4*)(ksrc + 8), x2a = *(const u32x4*)(ksrc + 32), x2b = *(const u32x4*)(ksrc + 40);
            float x1[16], x2[16], cs[16], sn[16];
            x1[0] = bflo(x1a.x); x1[1] = bfhi(x1a.x); x1[2] = bflo(x1a.y); x1[3] = bfhi(x1a.y); x1[4] = bflo(x1a.z); x1[5] = bfhi(x1a.z); x1[6] = bflo(x1a.w); x1[7] = bfhi(x1a.w);
            x1[8] = bflo(x1b.x); x1[9] = bfhi(x1b.x); x1[10] = bflo(x1b.y); x1[11] = bfhi(x1b.y); x1[12] = bflo(x1b.z); x1[13] = bfhi(x1b.z); x1[14] = bflo(x1b.w); x1[15] = bfhi(x1b.w);
            x2[0] = bflo(x2a.x); x2[1] = bfhi(x2a.x); x2[2] = bflo(x2a.y); x2[3] = bfhi(x2a.y); x2[4] = bflo(x2a.z); x2[5] = bfhi(x2a.z); x2[6] = bflo(x2a.w); x2[7] = bfhi(x2a.w);
            x2[8] = bflo(x2b.x); x2[9] = bfhi(x2b.x); x2[10] = bflo(x2b.y); x2[11] = bfhi(x2b.y); x2[12] = bflo(x2b.z); x2[13] = bfhi(x2b.z); x2[14] = bflo(x2b.w); x2[15] = bfhi(x2b.w);
#pragma unroll
            for (int q4 = 0; q4 < 4; ++q4) { const f32x4 cv = *(const f32x4*)(tcos + (size_t)tok * 32 + 16 * part + 4 * q4), sv = *(const f32x4*)(tsin + (size_t)tok * 32 + 16 * part + 4 * q4);
                cs[4 * q4] = cv.x; cs[4 * q4 + 1] = cv.y; cs[4 * q4 + 2] = cv.z; cs[4 * q4 + 3] = cv.w; sn[4 * q4] = sv.x; sn[4 * q4 + 1] = sv.y; sn[4 * q4 + 2] = sv.z; sn[4 * q4 + 3] = sv.w; }
            float o1[16], o2[16];
#pragma unroll
            for (int e = 0; e < 16; ++e) { o1[e] = x1[e] * cs[e] - x2[e] * sn[e]; o2[e] = x2[e] * cs[e] + x1[e] * sn[e]; }
            u32x4 wv;
            wv.x = cvt_pk_bf16(o1[0], o1[1]); wv.y = cvt_pk_bf16(o1[2], o1[3]); wv.z = cvt_pk_bf16(o1[4], o1[5]); wv.w = cvt_pk_bf16(o1[6], o1[7]); *(LAS u32x4*)(Ks + key * KS_LD + 16 * part) = wv;
            wv.x = cvt_pk_bf16(o1[8], o1[9]); wv.y = cvt_pk_bf16(o1[10], o1[11]); wv.z = cvt_pk_bf16(o1[12], o1[13]); wv.w = cvt_pk_bf16(o1[14], o1[15]); *(LAS u32x4*)(Ks + key * KS_LD + 16 * part + 8) = wv;
            wv.x = cvt_pk_bf16(o2[0], o2[1]); wv.y = cvt_pk_bf16(o2[2], o2[3]); wv.z = cvt_pk_bf16(o2[4], o2[5]); wv.w = cvt_pk_bf16(o2[6], o2[7]); *(LAS u32x4*)(Ks + key * KS_LD + 32 + 16 * part) = wv;
            wv.x = cvt_pk_bf16(o2[8], o2[9]); wv.y = cvt_pk_bf16(o2[10], o2[11]); wv.z = cvt_pk_bf16(o2[12], o2[13]); wv.w = cvt_pk_bf16(o2[14], o2[15]); *(LAS u32x4*)(Ks + key * KS_LD + 32 + 16 * part + 8) = wv;
            const bf16_t* vsrc = proj + (size_t)tok * D_IN + OFF_V + hk * 64 + 32 * part;
#pragma unroll
            for (int q4 = 0; q4 < 4; ++q4) { const u32x4 vv = *(const u32x4*)(vsrc + 8 * q4); LAS bf16_t* vd = Vt + (32 * part + 8 * q4) * VT_LD + key;
                vd[0 * VT_LD] = (bf16_t)(vv.x & 0xffffu); vd[1 * VT_LD] = (bf16_t)(vv.x >> 16); vd[2 * VT_LD] = (bf16_t)(vv.y & 0xffffu); vd[3 * VT_LD] = (bf16_t)(vv.y >> 16);
                vd[4 * VT_LD] = (bf16_t)(vv.z & 0xffffu); vd[5 * VT_LD] = (bf16_t)(vv.z >> 16); vd[6 * VT_LD] = (bf16_t)(vv.w & 0xffffu); vd[7 * VT_LD] = (bf16_t)(vv.w >> 16); }
        }
    }
#pragma unroll
    for (int i = 0; i < 2; ++i) { const int idx = tid + 512 * i, tk = idx >> 3, f4 = idx & 7;
        *(LAS f32x4*)(lds + TC_OFF + tk * TAB_LDB + f4 * 16) = *(const f32x4*)(tcos + (size_t)tok0 * 32 + idx * 4);
        *(LAS f32x4*)(lds + TS_OFF + tk * TAB_LDB + f4 * 16) = *(const f32x4*)(tsin + (size_t)tok0 * 32 + idx * 4); }
    __syncthreads();
#pragma unroll 1
    for (int qq = 0; qq < 4; ++qq) {
        bf16_t* obase = (bf16_t*)(a.ws + WS_H) + (size_t)(tok0 + 32 * qq + (lane >> 3)) * 2048 + hq * 64 + 8 * (lane & 7);
        bf16x8 qf[4];
#pragma unroll
        for (int it = 0; it < 4; ++it) *(LAS u32x4*)(stage + st_rw + it * 8 * ST_LDB) = qraw[it];
        u32x4 qfr[4]; f32x4 qc[4], qs[4];
#pragma unroll
        for (int dd = 0; dd < 4; ++dd) qfr[dd] = *(const LAS u32x4*)(stage + l32 * ST_LDB + (16 * dd + 8 * hi) * 2);
#pragma unroll
        for (int d2 = 0; d2 < 2; ++d2) { const int to = (32 * qq + l32) * TAB_LDB + (16 * d2 + 8 * hi) * 4;
            qc[2 * d2] = *(const LAS f32x4*)(lds + TC_OFF + to); qc[2 * d2 + 1] = *(const LAS f32x4*)(lds + TC_OFF + to + 16);
            qs[2 * d2] = *(const LAS f32x4*)(lds + TS_OFF + to); qs[2 * d2 + 1] = *(const LAS f32x4*)(lds + TS_OFF + to + 16); }
#pragma unroll
        for (int d2 = 0; d2 < 2; ++d2) {
            const f32x4 c0 = qc[2 * d2], c1 = qc[2 * d2 + 1], s0 = qs[2 * d2], s1 = qs[2 * d2 + 1];
            const float cs[8] = {c0.x, c0.y, c0.z, c0.w, c1.x, c1.y, c1.z, c1.w}, sn[8] = {s0.x, s0.y, s0.z, s0.w, s1.x, s1.y, s1.z, s1.w};
            const u32x4 r1 = qfr[d2], r2 = qfr[d2 + 2];
            const float x1[8] = {bflo(r1.x), bfhi(r1.x), bflo(r1.y), bfhi(r1.y), bflo(r1.z), bfhi(r1.z), bflo(r1.w), bfhi(r1.w)};
            const float x2[8] = {bflo(r2.x), bfhi(r2.x), bflo(r2.y), bfhi(r2.y), bflo(r2.z), bfhi(r2.z), bflo(r2.w), bfhi(r2.w)};
            float o1[8], o2[8];
#pragma unroll
            for (int e = 0; e < 8; ++e) { o1[e] = x1[e] * cs[e] - x2[e] * sn[e]; o2[e] = x2[e] * cs[e] + x1[e] * sn[e]; }
            u32x4 w1, w2;
            w1.x = cvt_pk_bf16(o1[0], o1[1]); w1.y = cvt_pk_bf16(o1[2], o1[3]); w1.z = cvt_pk_bf16(o1[4], o1[5]); w1.w = cvt_pk_bf16(o1[6], o1[7]);
            w2.x = cvt_pk_bf16(o2[0], o2[1]); w2.y = cvt_pk_bf16(o2[2], o2[3]); w2.z = cvt_pk_bf16(o2[4], o2[5]); w2.w = cvt_pk_bf16(o2[6], o2[7]);
            qf[d2] = __builtin_bit_cast(bf16x8, w1); qf[d2 + 2] = __builtin_bit_cast(bf16x8, w2);
        }
        if (qq < 3) ATT_LOADQ(qq + 1);
        f32x16 s[5];
#pragma unroll
        for (int kbi = 0; kbi < 5; ++kbi) {
#pragma unroll
            for (int i = 0; i < 16; ++i) s[kbi][i] = 0.f;
            const LAS bf16_t* kp = Ks + (32 * (qq + kbi) + l32) * KS_LD + 8 * hi;
#pragma unroll
            for (int dd = 0; dd < 4; ++dd) { const bf16x8 kf = *(const LAS bf16x8*)(kp + 16 * dd); s[kbi] = __builtin_amdgcn_mfma_f32_32x32x16_bf16(kf, qf[dd], s[kbi], 0, 0, 0); }
        }
        if (nb == 0) {
#pragma unroll
            for (int kbi = 0; kbi < 4; ++kbi) if (qq + kbi < 4) {
#pragma unroll
                for (int i = 0; i < 16; ++i) s[kbi][i] = -1e30f; }
        }
        const int tq = l32 - 4 * hi;
#pragma unroll
        for (int i = 0; i < 16; ++i) { const int rr = 8 * (i >> 2) + (i & 3); s[0][i] = (rr > tq) ? s[0][i] : -1e30f; s[4][i] = (rr <= tq) ? s[4][i] : -1e30f; }
        float mx = -1e30f;
#pragma unroll
        for (int kbi = 0; kbi < 5; ++kbi)
#pragma unroll
            for (int i = 0; i < 16; i += 2) mx = fmaxf(mx, fmaxf(s[kbi][i], s[kbi][i + 1]));
        mx = fmaxf(mx, __shfl_xor(mx, 32)); mx = fmaxf(mx * CS, sink2);
        const float nmx = -mx;
        float lsum = 0.f;
        bf16x8 pk[5][2];
#pragma unroll
        for (int kbi = 0; kbi < 5; ++kbi) {
#pragma unroll
            for (int i = 0; i < 16; ++i) { const float p = __builtin_amdgcn_exp2f(fmaf(s[kbi][i], CS, nmx)); s[kbi][i] = p; lsum += p; }
#pragma unroll
            for (int j2 = 0; j2 < 2; ++j2) { u32x4 pw;
                pw.x = cvt_pk_bf16(s[kbi][8 * j2 + 0], s[kbi][8 * j2 + 1]); pw.y = cvt_pk_bf16(s[kbi][8 * j2 + 2], s[kbi][8 * j2 + 3]);
                pw.z = cvt_pk_bf16(s[kbi][8 * j2 + 4], s[kbi][8 * j2 + 5]); pw.w = cvt_pk_bf16(s[kbi][8 * j2 + 6], s[kbi][8 * j2 + 7]);
                pk[kbi][j2] = __builtin_bit_cast(bf16x8, pw); }
        }
        lsum += __shfl_xor(lsum, 32); lsum += __builtin_amdgcn_exp2f(sink2 - mx);
        const float inv = 1.0f / lsum;
        f32x16 o[2];
#pragma unroll
        for (int db = 0; db < 2; ++db)
#pragma unroll
            for (int i = 0; i < 16; ++i) o[db][i] = 0.f;
#pragma unroll
        for (int kbi = 0; kbi < 5; ++kbi)
#pragma unroll
            for (int j2 = 0; j2 < 2; ++j2)
#pragma unroll
                for (int db = 0; db < 2; ++db) {
                    const LAS bf16_t* vp = Vt + (32 * db + l32) * VT_LD + 32 * (qq + kbi) + 16 * j2 + 4 * hi;
                    const s16x4 lo = *(const LAS s16x4*)vp, hh = *(const LAS s16x4*)(vp + 8);
                    const bf16x8 vf = (bf16x8){lo[0], lo[1], lo[2], lo[3], hh[0], hh[1], hh[2], hh[3]};
                    o[db] = __builtin_amdgcn_mfma_f32_32x32x16_bf16(vf, pk[kbi][j2], o[db], 0, 0, 0);
                }
#pragma unroll
        for (int db = 0; db < 2; ++db)
#pragma unroll
            for (int g = 0; g < 4; ++g) { u32x2 wv; wv.x = cvt_pk_bf16(o[db][4 * g] * inv, o[db][4 * g + 1] * inv); wv.y = cvt_pk_bf16(o[db][4 * g + 2] * inv, o[db][4 * g + 3] * inv);
                *(LAS u32x2*)(stage + l32 * ST_LDB + (32 * db + 8 * g + 4 * hi) * 2) = wv; }
#pragma unroll
        for (int it = 0; it < 4; ++it) { const u32x4 ov = *(const LAS u32x4*)(stage + st_rw + it * 8 * ST_LDB); *(u32x4*)(obase + (size_t)(8 * it) * 2048) = ov; }
    }
    __syncthreads();
#undef ATT_LOADQ
}

__device__ __forceinline__ void grid_barrier(unsigned* ctr, unsigned target) {
    asm volatile("s_waitcnt vmcnt(0) lgkmcnt(0)" ::: "memory");
    __syncthreads();
    if (threadIdx.x == 0) {
        __builtin_amdgcn_fence(__ATOMIC_RELEASE, "agent");
        asm volatile("s_waitcnt vmcnt(0)" ::: "memory");
        __hip_atomic_fetch_add(ctr, 1u, __ATOMIC_RELAXED, __HIP_MEMORY_SCOPE_AGENT);
        while (__hip_atomic_load(ctr, __ATOMIC_RELAXED, __HIP_MEMORY_SCOPE_AGENT) < target) __builtin_amdgcn_s_sleep(2);
        __builtin_amdgcn_fence(__ATOMIC_ACQUIRE, "agent");
        asm volatile("s_waitcnt vmcnt(0)" ::: "memory");
    }
    __syncthreads();
}
#define GRID_SYNC_CG() do { asm volatile("s_waitcnt vmcnt(0) lgkmcnt(0)" ::: "memory"); grid.sync(); __builtin_amdgcn_fence(__ATOMIC_ACQUIRE, "agent"); asm volatile("s_waitcnt vmcnt(0)" ::: "memory"); } while (0)
#define GRID_SYNC() do { ++bar_k; grid_barrier(bar_ctr, bar_k * (unsigned)gridDim.x); } while (0)
__global__ void __launch_bounds__(512, 2) fwd_megakernel(Args a) {
    extern __shared__ __attribute__((aligned(16))) unsigned char lds_raw[];
    LAS unsigned char* lds = (LAS unsigned char*)lds_raw;
    cg::grid_group grid = cg::this_grid();
    const int tid = threadIdx.x, lane = tid & 63, wave = __builtin_amdgcn_readfirstlane(tid >> 6);
    const int G = gridDim.x, bx = blockIdx.x;
    const int gw = bx * 8 + wave, NGW = G * 8;
    bf16_t* proj = (bf16_t*)(a.ws + WS_P);
    bf16_t* Hb = (bf16_t*)(a.ws + WS_H);
    unsigned* bar_ctr = (unsigned*)(a.ws + WS_CTL); unsigned bar_k = 0;

    for (int rep_ = 0; rep_ < REP_A; ++rep_) {
    {
        LAS float* scr = (LAS float*)(lds + wave * 16384);
        constexpr int I_IN = (D_MODEL / 64) * (D_IN / 32), I_SQ = (2048 / 64) * (2048 / 32), I_UP = (D_MODEL / 64) * (D_FF / 32), I_DN = (D_FF / 64) * (D_MODEL / 32);
        constexpr int NITEMS = I_IN + 3 * I_SQ + I_UP + I_DN;
        for (int it = gw; it < NITEMS; it += NGW) {
            int r = it;
            if (r < I_IN) { p0_transpose_item(a.w_in, D_MODEL, D_IN, (bf16_t*)(a.ws + WS_WIN), scr, r, lane); continue; } r -= I_IN;
            if (r < I_SQ) { p0_transpose_item(a.w_rnn, 2048, 2048, (bf16_t*)(a.ws + WS_WRNN), scr, r, lane); continue; } r -= I_SQ;
            if (r < I_SQ) { p0_transpose_item(a.w_attn, 2048, 2048, (bf16_t*)(a.ws + WS_WATT), scr, r, lane); continue; } r -= I_SQ;
            if (r < I_SQ) { p0_transpose_item(a.w_out, 2048, 2048, (bf16_t*)(a.ws + WS_WOUT), scr, r, lane); continue; } r -= I_SQ;
            if (r < I_UP) { p0_transpose_item(a.w_up, D_MODEL, D_FF, (bf16_t*)(a.ws + WS_WUP), scr, r, lane); continue; } r -= I_UP;
            p0_transpose_item(a.w_down, D_FF, D_MODEL, (bf16_t*)(a.ws + WS_WDN), scr, r, lane);
        }
        for (int v = bx * 512 + tid; v < 2 * 65536; v += G * 512) {
            const int gate = v >> 16, r = v & 65535, ln = r & 63, kk = (r >> 6) & 15, wv = (r >> 10) & 7, nb = r >> 13;
            const float* src = (gate ? a.w_rg_x : a.w_rg_a) + (size_t)nb * 65536 + (size_t)(16 * kk + 8 * (ln >> 5)) * 256 + 32 * wv + (ln & 31);
            float e[8];
#pragma unroll
            for (int q = 0; q < 8; ++q) e[q] = src[q * 256] * (-LOG2E);
            u32x4 o; o.x = cvt_pk_bf16(e[0], e[1]); o.y = cvt_pk_bf16(e[2], e[3]); o.z = cvt_pk_bf16(e[4], e[5]); o.w = cvt_pk_bf16(e[6], e[7]);
            *(u32x4*)((bf16_t*)(a.ws + (gate ? WS_WRGX : WS_WRGA)) + (size_t)r * 8) = o;
        }
        for (int m = gw; m < M_TOK; m += NGW) rms_row_to_bf16(a.x + (size_t)m * D_MODEL, a.g_pre, Hb + (size_t)m * D_MODEL, lane);
        float* tcos = (float*)(a.ws + WS_COS); float* tsin = (float*)(a.ws + WS_SIN);
        for (int i = bx * 512 + tid; i < M_TOK * 32; i += G * 512) {
            const int tok = i >> 5, f = i & 31;
            const float inv_freq = exp2f(-(float)f * (13.287712379549449f / 32.0f));
            const float ang = (float)a.pos[tok] * inv_freq;
            float sv, cv; sincosf(ang, &sv, &cv); tcos[i] = cv; tsin[i] = sv;
        }
    }
    GRID_SYNC_CG();
    }
    for (int rep_ = 0; rep_ < REP_G; ++rep_) {
    {
        pg8::Gemm g{Hb, (const bf16_t*)(a.ws + WS_WIN), M_TOK, D_IN, D_MODEL, D_MODEL}; pg8::StaticOrder S; S.init(M_TOK, D_IN, G, bx);
        pg8::EpiBf16 E{proj, D_IN, 0};
        pg8::gemm_phase<pg8::EpiBf16>(lds, g, S, E);
    }
    GRID_SYNC();
    }
    for (int rep_ = 0; rep_ < REP_B; ++rep_) {
    for (int it = bx; it < 256 * 8; it += G) rnn_tile(a, lds, it >> 3, it & 7);
    GRID_SYNC();
    }
    for (int rep_ = 0; rep_ < REP_C; ++rep_) {
    {
        if (tid < 32) {
            const int gi = bx * 32 + tid;
            if (gi < BATCH * D_RNN) {
                const int b = gi / D_RNN, ch = gi % D_RNN;
                const float* sa = (const float*)(a.ws + WS_SUMA) + (size_t)b * 64 * D_RNN + ch; const float* sb = (const float*)(a.ws + WS_SUMB) + (size_t)b * 64 * D_RNN + ch;
                float* hin = (float*)(a.ws + WS_HIN) + (size_t)b * 64 * D_RNN + ch;
                float H = 0.f;
                for (int j0 = 0; j0 < 64; j0 += 8) {
                    float av[8], bv[8];
#pragma unroll
                    for (int j = 0; j < 8; ++j) { av[j] = sa[(size_t)(j0 + j) * D_RNN]; bv[j] = sb[(size_t)(j0 + j) * D_RNN]; }
#pragma unroll
                    for (int j = 0; j < 8; ++j) { hin[(size_t)(j0 + j) * D_RNN] = H; H = H * av[j] + bv[j]; }
                }
            }
        }
        for (int it = bx; it < 1024; it += G) attn_item(a, lds, it);
    }
    GRID_SYNC();
    }
    rnn_fixup(a, bx, G);
    GRID_SYNC();
    {
        pg8::StaticOrder S; S.init(M_TOK, D_MODEL, G, bx);
        { pg8::Gemm g{proj + OFF_YR, (const bf16_t*)(a.ws + WS_WRNN), M_TOK, D_MODEL, D_RNN, D_IN};
          pg8::EpiGate E{proj + OFF_GR, nullptr, D_IN}; pg8::gemm_phase<pg8::EpiGate>(lds, g, S, E); }
        { pg8::Gemm g{Hb, (const bf16_t*)(a.ws + WS_WATT), M_TOK, D_MODEL, 2048, 2048};
          pg8::EpiGate E{proj + OFF_GA, proj + OFF_GR, D_IN}; pg8::gemm_phase<pg8::EpiGate>(lds, g, S, E); }
    }
    GRID_SYNC();
    for (int rep_ = 0; rep_ < REP_G; ++rep_) {
    {
        pg8::Gemm g{proj + OFF_GA, (const bf16_t*)(a.ws + WS_WOUT), M_TOK, D_MODEL, D_MODEL, D_IN}; pg8::StaticOrder S; S.init(M_TOK, D_MODEL, G, bx);
        pg8::EpiBf16 E{Hb, D_MODEL, 4}; pg8::gemm_phase<pg8::EpiBf16>(lds, g, S, E);
    }
    GRID_SYNC();
    }
    for (int m = gw; m < M_TOK; m += NGW) {
        const f32x4* xr = (const f32x4*)(a.x + (size_t)m * D_MODEL) + lane;
        const u32x2* tb = (const u32x2*)(Hb + (size_t)m * D_MODEL) + lane; u32x2* x1w = (u32x2*)((bf16_t*)(a.ws + WS_X1) + (size_t)m * D_MODEL) + lane;
        const f32x4* g1 = (const f32x4*)a.g_post + lane; const f32x4* g2 = (const f32x4*)a.g_mlp_pre + lane;
        f32x4 v[8]; float s = 0.f;
#pragma unroll
        for (int j = 0; j < 8; ++j) { const u32x2 t2 = tb[64 * j]; v[j] = (f32x4){bflo(t2.x), bfhi(t2.x), bflo(t2.y), bfhi(t2.y)}; s += (v[j].x * v[j].x + v[j].y * v[j].y) + (v[j].z * v[j].z + v[j].w * v[j].w); }
        const float rstd = 1.0f / sqrtf(wave_sum(s) * (1.f / D_MODEL) + RMS_EPS);
        float s2 = 0.f;
#pragma unroll
        for (int j = 0; j < 8; ++j) { const f32x4 xx = xr[64 * j], gg = g1[64 * j]; v[j] = xx + v[j] * rstd * gg;
            u32x2 w1; w1.x = cvt_pk_bf16(v[j].x, v[j].y); w1.y = cvt_pk_bf16(v[j].z, v[j].w); x1w[64 * j] = w1;
            s2 += (v[j].x * v[j].x + v[j].y * v[j].y) + (v[j].z * v[j].z + v[j].w * v[j].w); }
        const float rstd2 = 1.0f / sqrtf(wave_sum(s2) * (1.f / D_MODEL) + RMS_EPS);
        u32x2* o8 = (u32x2*)(Hb + (size_t)m * D_MODEL) + lane;
#pragma unroll
        for (int j = 0; j < 8; ++j) { const f32x4 gg = g2[64 * j]; u32x2 w; w.x = cvt_pk_bf16(v[j].x * rstd2 * gg.x, v[j].y * rstd2 * gg.y); w.y = cvt_pk_bf16(v[j].z * rstd2 * gg.z, v[j].w * rstd2 * gg.w); o8[64 * j] = w; }
    }
    GRID_SYNC();
    for (int rep_ = 0; rep_ < REP_G; ++rep_) {
    {
        pg8::Gemm g{Hb, (const bf16_t*)(a.ws + WS_WUP), M_TOK, D_FF, D_MODEL, D_MODEL}; pg8::StaticOrder S; S.init(M_TOK, D_FF, G, bx);
        pg8::EpiBf16 E{(bf16_t*)(a.ws + WS_U), D_FF, 3}; pg8::gemm_phase<pg8::EpiBf16>(lds, g, S, E);
    }
    GRID_SYNC();
    }
    for (int rep_ = 0; rep_ < REP_G; ++rep_) {
    {
        pg8::Gemm g{(const bf16_t*)(a.ws + WS_U), (const bf16_t*)(a.ws + WS_WDN), M_TOK, D_MODEL, D_FF, D_FF}; pg8::StaticOrder S; S.init(M_TOK, D_MODEL, G, bx);
        pg8::EpiBf16 E{(bf16_t*)(a.ws + WS_D), D_MODEL, 4}; pg8::gemm_phase<pg8::EpiBf16>(lds, g, S, E);
    }
    GRID_SYNC();
    }
    for (int m = gw; m < M_TOK; m += NGW) {
        f32x4* orow = (f32x4*)(a.out + (size_t)m * D_MODEL) + lane; const u32x2* dr = (const u32x2*)((const bf16_t*)(a.ws + WS_D) + (size_t)m * D_MODEL) + lane;
        const f32x4* g1 = (const f32x4*)a.g_mlp_post + lane; const u32x2* x1b = (const u32x2*)((const bf16_t*)(a.ws + WS_X1) + (size_t)m * D_MODEL) + lane;
        f32x4 v[8]; float s = 0.f;
#pragma unroll
        for (int j = 0; j < 8; ++j) { const u32x2 t2 = dr[64 * j]; v[j] = (f32x4){bflo(t2.x), bfhi(t2.x), bflo(t2.y), bfhi(t2.y)}; s += (v[j].x * v[j].x + v[j].y * v[j].y) + (v[j].z * v[j].z + v[j].w * v[j].w); }
        const float rstd = 1.0f / sqrtf(wave_sum(s) * (1.f / D_MODEL) + RMS_EPS);
#pragma unroll
        for (int j = 0; j < 8; ++j) { const f32x4 gg = g1[64 * j]; const u32x2 x2 = x1b[64 * j]; const f32x4 x1 = (f32x4){bflo(x2.x), bfhi(x2.x), bflo(x2.y), bfhi(x2.y)}; orow[64 * j] = x1 + v[j] * rstd * gg; }
    }
}

extern "C" void kernel_launch(void* const* d_in, const int* in_sizes, int n_in, void* d_out, int out_size, void* d_ws, size_t ws_size, hipStream_t stream) {
    static int grid_blocks = 0;
    if (grid_blocks == 0) {
        if (n_in != 20 || in_sizes[0] != M_TOK * D_MODEL || out_size != M_TOK * D_MODEL || ws_size < WS_END) {
            fprintf(stderr, "kernel_launch: unexpected shapes: n_in %d in0 %d out %d ws %zu (need %zu)\n", n_in, n_in > 0 ? in_sizes[0] : -1, out_size, ws_size, (size_t)WS_END); grid_blocks = -1; return; }
        int dev = 0, cus = 0, per_cu = 0;
        (void)hipGetDevice(&dev);
        (void)hipDeviceGetAttribute(&cus, hipDeviceAttributeMultiprocessorCount, dev);
        if (hipFuncSetAttribute((const void*)fwd_megakernel, hipFuncAttributeMaxDynamicSharedMemorySize, LDS_BYTES) != hipSuccess) fprintf(stderr, "kernel_launch: hipFuncSetAttribute failed\n");
        if (hipOccupancyMaxActiveBlocksPerMultiprocessor(&per_cu, (const void*)fwd_megakernel, 512, LDS_BYTES) != hipSuccess || per_cu < 1) { fprintf(stderr, "kernel_launch: occupancy query gave %d\n", per_cu); per_cu = 1; }
        (void)hipGetLastError();
        grid_blocks = cus * per_cu;
    }
    if (grid_blocks < 0) return;
    Args a{};
    a.x = (const float*)d_in[0]; a.pos = (const int*)d_in[1]; a.g_pre = (const float*)d_in[2]; a.w_in = (const float*)d_in[3]; a.conv_w = (const float*)d_in[4]; a.conv_b = (const float*)d_in[5];
    a.w_rg_a = (const float*)d_in[6]; a.b_rg_a = (const float*)d_in[7]; a.w_rg_x = (const float*)d_in[8]; a.b_rg_x = (const float*)d_in[9]; a.lam = (const float*)d_in[10]; a.sinks = (const float*)d_in[11];
    a.w_rnn = (const float*)d_in[12]; a.w_attn = (const float*)d_in[13]; a.w_out = (const float*)d_in[14]; a.g_post = (const float*)d_in[15]; a.g_mlp_pre = (const float*)d_in[16];
    a.w_up = (const float*)d_in[17]; a.w_down = (const float*)d_in[18]; a.g_mlp_post = (const float*)d_in[19];
    a.out = (float*)d_out; a.ws = (unsigned char*)d_ws;
    if (hipMemsetAsync((char*)d_ws + WS_CTL, 0, 256, stream) != hipSuccess) { fprintf(stderr, "kernel_launch: memset failed\n"); return; }
    void* args[] = {&a};
    hipError_t e = hipLaunchCooperativeKernel((const void*)fwd_megakernel, dim3(grid_blocks), dim3(512), args, LDS_BYTES, stream);
    if (e != hipSuccess) fprintf(stderr, "cooperative launch failed: %s (grid %d)\n", hipGetErrorString(e), grid_blocks);
}
```

```cpp
#include <hip/hip_runtime.h>
#include <hip/hip_cooperative_groups.h>
#include <cstdio>
#include <cstdint>
namespace cg = cooperative_groups;

#define LAS __attribute__((address_space(3)))
typedef unsigned short bf16_t;
typedef short bf16x8 __attribute__((ext_vector_type(8)));
typedef short s16x4 __attribute__((ext_vector_type(4)));
typedef float f32x4 __attribute__((ext_vector_type(4)));
typedef float f32x2 __attribute__((ext_vector_type(2)));
typedef float f32x16 __attribute__((ext_vector_type(16)));
typedef unsigned u32x4 __attribute__((ext_vector_type(4)));
typedef unsigned u32x2 __attribute__((ext_vector_type(2)));

constexpr int D_MODEL = 2048, BATCH = 4, SEQ = 8192, M_TOK = BATCH * SEQ;
constexpr int D_RNN = 2048, D_FF = 8192, D_IN = 10752;
constexpr int OFF_XR = 0, OFF_YR = 2048, OFF_Q = 4096, OFF_K = 6144, OFF_V = 6400, OFF_GR = 6656, OFF_GA = 8704;
constexpr float RMS_EPS = 1e-6f;
constexpr float LOG2E = 1.4426950408889634f;

constexpr size_t MiB = 1u << 20;
constexpr size_t WS_COS = 0, WS_SIN = 4 * MiB, WS_SUMA = 8 * MiB, WS_SUMB = 10 * MiB, WS_HIN = 12 * MiB;
constexpr size_t WS_WRGA = 14 * MiB, WS_WRGX = 15 * MiB, WS_WIN = 16 * MiB, WS_WRNN = 58 * MiB, WS_WATT = 66 * MiB, WS_WOUT = 74 * MiB;
constexpr size_t WS_WUP = 82 * MiB, WS_WDN = 114 * MiB, WS_P = 146 * MiB, WS_H = 818 * MiB, WS_U = 146 * MiB, WS_D = 818 * MiB, WS_X1 = 658 * MiB, WS_CTL = 946 * MiB, WS_END = 947 * MiB;

constexpr int LDS_BYTES = 147456;
#ifndef REP_G
#define REP_G 1
#endif
#ifndef REP_A
#define REP_A 1
#endif
#ifndef REP_B
#define REP_B 1
#endif
#ifndef REP_C
#define REP_C 1
#endif

typedef __bf16 bf16x2_t __attribute__((ext_vector_type(2)));
__device__ __forceinline__ unsigned cvt_pk_bf16(float lo, float hi) { const f32x2 v = {lo, hi}; const bf16x2_t b = __builtin_convertvector(v, bf16x2_t); return __builtin_bit_cast(unsigned, b); }
__device__ __forceinline__ float bf2f(unsigned short b) { return __uint_as_float(((unsigned)b) << 16); }
__device__ __forceinline__ float bflo(unsigned w) { return __uint_as_float(w << 16); }
__device__ __forceinline__ float bfhi(unsigned w) { return __uint_as_float(w & 0xffff0000u); }
__device__ __forceinline__ float sigmoidf_(float v) { return __builtin_amdgcn_rcpf(1.0f + __builtin_amdgcn_exp2f(-v * LOG2E)); }
__device__ __forceinline__ float gelu_tanh(float v) { const float u = 1.5957691216057308f * (v + 0.044715f * v * v * v); return v * sigmoidf_(u); }
__device__ __forceinline__ float wave_sum(float v) {
#pragma unroll
    for (int o = 1; o < 64; o <<= 1) v += __shfl_xor(v, o);
    return v;
}

namespace pg8 {
constexpr int BM = 256, BK = 64, HALF = 128, HTB = HALF * BK * 2, STAGE_BYTES = 8 * HTB, NXCD = 8, WGM = 8;
__host__ __device__ __forceinline__ int lds_byte(int r, int c) { const int st = (r >> 4) * 2 + (c >> 5), rr = r & 15, cc = c & 31, ob = rr * 64 + cc * 2; return st * 1024 + (ob ^ (((ob >> 9) & 1) << 5)); }
__host__ __device__ __forceinline__ void stage_rc(int b, int& R, int& C) { const int st = b / 1024, sb = b % 1024, swz = sb ^ (((sb >> 9) & 1) << 5); R = (st >> 1) * 16 + swz / 64; C = (st & 1) * 32 + (swz % 64) / 2; }
__host__ __device__ __forceinline__ int perm32(int rho) { const int n = rho >> 4, i = rho & 15; return 8 * (i >> 2) + 4 * n + (i & 3); }

struct Unit { int pm, pn; };
struct Gemm { const bf16_t* A; const bf16_t* Bt; int M, N, K, lda; };

struct StaticOrder {
    int nM, nN, nwg, G, c;
    __device__ void init(int M, int N, int G_, int c_) { nM = M / BM; nN = N / BM; nwg = nM * nN; G = G_; c = c_; }
    __device__ bool next(int i, Unit& u) const {
        const long L = (long)i * G + c; if (L >= nwg) return false;
        int wgid = (int)L; { const int q = nwg / NXCD, r = nwg % NXCD, xcd = wgid % NXCD, off = wgid / NXCD; wgid = (xcd < r ? xcd * (q + 1) : r * (q + 1) + (xcd - r) * q) + off; }
        const int nig = WGM * nN, gid = wgid / nig, fm = gid * WGM, gsz = (nM - fm) < WGM ? (nM - fm) : WGM;
        u.pm = fm + ((wgid % nig) % gsz); u.pn = (wgid % nig) / gsz; return true;
    }
};

struct EpiBf16 {
    static constexpr bool PERM = true;
    bf16_t* O; int ldc; int mode;
    template <int ACT> __device__ __forceinline__ void run(const f32x4 (&acc)[2][2][4][2], const Unit& u, int wr, int wc, int fr, int fq) const {
        const int row0 = u.pm * BM + wr * 64 + fr, col0 = u.pn * BM + wc * 32 + 8 * fq;
#pragma unroll
        for (int ai = 0; ai < 2; ++ai)
#pragma unroll
            for (int m = 0; m < 4; ++m) { bf16_t* rowp = O + (size_t)(row0 + ai * HALF + m * 16) * ldc + col0;
#pragma unroll
                for (int bj = 0; bj < 2; ++bj) { f32x4 v0 = acc[ai][bj][m][0], v1 = acc[ai][bj][m][1];
#pragma unroll
                    for (int e = 0; e < 4; ++e) {
                        if (ACT == 1) { v0[e] = gelu_tanh(v0[e]); v1[e] = gelu_tanh(v1[e]); }
                        if (ACT == 2) { v0[e] = sigmoidf_(v0[e]); v1[e] = sigmoidf_(v1[e]); }
                        if (ACT == 3) { const float a0 = fmaxf(v0[e], 0.f), a1 = fmaxf(v1[e], 0.f); v0[e] = a0 * a0; v1[e] = a1 * a1; }
                    }
                    u32x4 w; w.x = cvt_pk_bf16(v0[0], v0[1]); w.y = cvt_pk_bf16(v0[2], v0[3]); w.z = cvt_pk_bf16(v1[0], v1[1]); w.w = cvt_pk_bf16(v1[2], v1[3]);
                    *(u32x4*)(rowp + bj * HALF) = w; } }
    }
    __device__ __forceinline__ void operator()(const f32x4 (&acc)[2][2][4][2], const Unit& u, int wr, int wc, int fr, int fq) const {
        if (mode == 3) { run<3>(acc, u, wr, wc, fr, fq); return; }
        if (mode == 4) { run<0>(acc, u, wr, wc, fr, fq); return; }
        const int seg = u.pn;
        if (seg >= 8 && seg < 16) run<1>(acc, u, wr, wc, fr, fq);
        else if (seg >= 26) run<2>(acc, u, wr, wc, fr, fq);
        else run<0>(acc, u, wr, wc, fr, fq);
    }
};
struct EpiGate {
    static constexpr bool PERM = true;
    bf16_t* G; const bf16_t* P; int ld;
    __device__ __forceinline__ void operator()(const f32x4 (&acc)[2][2][4][2], const Unit& u, int wr, int wc, int fr, int fq) const {
        const int row0 = u.pm * BM + wr * 64 + fr, col0 = u.pn * BM + wc * 32 + 8 * fq;
#pragma unroll
        for (int ai = 0; ai < 2; ++ai)
#pragma unroll
            for (int m = 0; m < 4; ++m) { const size_t ro = (size_t)(row0 + ai * HALF + m * 16) * ld + col0;
#pragma unroll
                for (int bj = 0; bj < 2; ++bj) { const f32x4 v0 = acc[ai][bj][m][0], v1 = acc[ai][bj][m][1];
                    const u32x4 g = *(const u32x4*)(G + ro + bj * HALF);
                    float o[8];
                    o[0] = bflo(g.x) * v0[0]; o[1] = bfhi(g.x) * v0[1]; o[2] = bflo(g.y) * v0[2]; o[3] = bfhi(g.y) * v0[3];
                    o[4] = bflo(g.z) * v1[0]; o[5] = bfhi(g.z) * v1[1]; o[6] = bflo(g.w) * v1[2]; o[7] = bfhi(g.w) * v1[3];
                    if (P) { const u32x4 p = *(const u32x4*)(P + ro + bj * HALF);
                        o[0] += bflo(p.x); o[1] += bfhi(p.x); o[2] += bflo(p.y); o[3] += bfhi(p.y); o[4] += bflo(p.z); o[5] += bfhi(p.z); o[6] += bflo(p.w); o[7] += bfhi(p.w); }
                    u32x4 w; w.x = cvt_pk_bf16(o[0], o[1]); w.y = cvt_pk_bf16(o[2], o[3]); w.z = cvt_pk_bf16(o[4], o[5]); w.w = cvt_pk_bf16(o[6], o[7]);
                    *(u32x4*)(G + ro + bj * HALF) = w; } }
    }
};
struct EpiF32 {
    static constexpr bool PERM = false;
    float* O; int ldc;
    __device__ __forceinline__ void operator()(const f32x4 (&acc)[2][2][4][2], const Unit& u, int wr, int wc, int fr, int fq) const {
        const int row0 = u.pm * BM + wr * 64 + fr, col0 = u.pn * BM + wc * 32 + 4 * fq;
#pragma unroll
        for (int ai = 0; ai < 2; ++ai)
#pragma unroll
            for (int m = 0; m < 4; ++m) { float* rowp = O + (size_t)(row0 + ai * HALF + m * 16) * ldc + col0;
#pragma unroll
                for (int bj = 0; bj < 2; ++bj)
#pragma unroll
                    for (int n = 0; n < 2; ++n) *(f32x4*)(rowp + bj * HALF + n * 16) = acc[ai][bj][m][n]; }
    }
};

template <class Epi>
__device__ __forceinline__ void gemm_phase(LAS unsigned char* lds, const Gemm g, const StaticOrder& S, const Epi& E) {
    int tid_ = threadIdx.x; asm volatile("" : "+v"(tid_));
    const int tid = tid_, wid = __builtin_amdgcn_readfirstlane(tid >> 6), lane = tid & 63, wr = wid >> 2, wc = wid & 3, fr = lane & 15, fq = lane >> 4;
    const int K = g.K, nt = K / BK, lda = g.lda;
    unsigned voffA[2], voffB[2];
#pragma unroll
    for (int i = 0; i < 2; ++i) { int R, C; stage_rc(tid * 16 + i * 8192, R, C); const int Rb = Epi::PERM ? ((R & ~31) + perm32(R & 31)) : R;
        voffA[i] = (unsigned)(R * lda + C) * 2u; voffB[i] = (unsigned)(Rb * K + C) * 2u; }
    const size_t kstep = (size_t)(BK * 2);
    const size_t hstepA = (size_t)HALF * lda * 2, hstepB = (size_t)HALF * K * 2;
    const size_t tstepA = 2 * hstepA, tstepB = 2 * hstepB;
    const unsigned ldsw = (unsigned)wid * 1024u;
    const int aoff = lds_byte(wr * 64 + fr, fq * 8), boff = lds_byte(wc * 32 + fr, fq * 8);
#define PG8_SA(b, h) (((b) * 2 + (h)) * HTB)
#define PG8_SB(b, h) ((4 + (b) * 2 + (h)) * HTB)
#define PG8_STAGE(bufoff, gbase, voff) do { _Pragma("unroll") for (int _i = 0; _i < 2; ++_i) \
        __builtin_amdgcn_global_load_lds((const unsigned*)((const char*)(gbase) + (voff)[_i]), (LAS unsigned*)(lds + (bufoff) + ldsw + _i * 8192), 16, 0, 0); } while (0)
#define PG8_LDA(dst, b, h) do { _Pragma("unroll") for (int m = 0; m < 4; ++m) _Pragma("unroll") for (int k = 0; k < 2; ++k) dst[m][k] = *(const LAS bf16x8*)(lds + PG8_SA(b, h) + aoff + m * 2048 + k * 1024); } while (0)
#define PG8_LDB(dst, b, h) do { _Pragma("unroll") for (int n = 0; n < 2; ++n) _Pragma("unroll") for (int k = 0; k < 2; ++k) dst[n][k] = *(const LAS bf16x8*)(lds + PG8_SB(b, h) + boff + n * 2048 + k * 1024); } while (0)
#define PG8_MMA(ai, bj, At, Bt) do { __builtin_amdgcn_s_setprio(1); _Pragma("unroll") for (int m = 0; m < 4; ++m) _Pragma("unroll") for (int n = 0; n < 2; ++n) _Pragma("unroll") for (int k = 0; k < 2; ++k) \
        acc[ai][bj][m][n] = __builtin_amdgcn_mfma_f32_16x16x32_bf16(Bt[n][k], At[m][k], acc[ai][bj][m][n], 0, 0, 0); __builtin_amdgcn_s_setprio(0); } while (0)
#define PG8_WAIT_V(n) asm volatile("s_waitcnt vmcnt(" #n ")" ::: "memory")
#define PG8_WAIT_L(n) asm volatile("s_waitcnt lgkmcnt(" #n ")" ::: "memory")
#define PG8_BAR __builtin_amdgcn_s_barrier()
#define PG8_SCHED __builtin_amdgcn_sched_barrier(0)
    Unit cur, nxt; int ui = 0;
    if (!S.next(0, cur)) return;
    f32x4 acc[2][2][4][2];
#pragma unroll
    for (int a = 0; a < 2; ++a)
#pragma unroll
        for (int b = 0; b < 2; ++b)
#pragma unroll
            for (int m = 0; m < 4; ++m)
#pragma unroll
                for (int n = 0; n < 2; ++n) acc[a][b][m][n] = (f32x4){0.f, 0.f, 0.f, 0.f};
    bf16x8 At[4][2], B0[2][2], B1[2][2];
    const char* cA = (const char*)g.A + (size_t)cur.pm * tstepA; const char* cB = (const char*)g.Bt + (size_t)cur.pn * tstepB;
    PG8_STAGE(PG8_SB(0, 0), cB, voffB); PG8_STAGE(PG8_SB(0, 1), cB + hstepB, voffB); PG8_STAGE(PG8_SA(0, 0), cA, voffA); PG8_STAGE(PG8_SA(0, 1), cA + hstepA, voffA);
    if (wr == 1) PG8_BAR;
    PG8_WAIT_V(2); PG8_BAR;
    PG8_STAGE(PG8_SB(1, 0), cB + kstep, voffB); PG8_STAGE(PG8_SA(1, 0), cA + kstep, voffA); PG8_STAGE(PG8_SB(1, 1), cB + hstepB + kstep, voffB);
    PG8_WAIT_V(6); PG8_BAR;
    for (;;) {
        const bool has_next = S.next(ui + 1, nxt);
        const char* nA = has_next ? (const char*)g.A + (size_t)nxt.pm * tstepA : cA; const char* nB = has_next ? (const char*)g.Bt + (size_t)nxt.pn * tstepB : cB;
        for (int t = 0; t < nt; t += 2) {
            const bool last = (t == nt - 2);
            const char* a1 = cA + (size_t)(t + 1) * kstep;
            const char* a2 = last ? nA : cA + (size_t)(t + 2) * kstep; const char* b2 = last ? nB : cB + (size_t)(t + 2) * kstep;
            const char* a3 = a2 + kstep; const char* b3 = b2 + kstep;
            PG8_STAGE(PG8_SA(1, 1), a1 + hstepA, voffA); PG8_SCHED; PG8_LDB(B0, 0, 0); PG8_LDB(B1, 0, 1); PG8_SCHED; PG8_LDA(At, 0, 0);
            PG8_WAIT_V(8); PG8_WAIT_L(0); PG8_BAR; PG8_MMA(0, 0, At, B0); PG8_MMA(0, 1, At, B1); PG8_BAR; PG8_SCHED;
            PG8_STAGE(PG8_SB(0, 0), b2, voffB); PG8_STAGE(PG8_SB(0, 1), b2 + hstepB, voffB); PG8_STAGE(PG8_SA(0, 0), a2, voffA); PG8_SCHED; PG8_LDA(At, 0, 1);
            PG8_WAIT_V(8); PG8_WAIT_L(0); PG8_BAR; PG8_MMA(1, 0, At, B0); PG8_MMA(1, 1, At, B1); PG8_BAR; PG8_SCHED;
            PG8_STAGE(PG8_SA(0, 1), a2 + hstepA, voffA); PG8_SCHED; PG8_LDB(B0, 1, 0); PG8_LDB(B1, 1, 1); PG8_SCHED; PG8_LDA(At, 1, 0);
            PG8_WAIT_V(8); PG8_WAIT_L(0); PG8_BAR; PG8_MMA(0, 0, At, B0); PG8_MMA(0, 1, At, B1); PG8_BAR; PG8_SCHED;
            PG8_STAGE(PG8_SB(1, 0), b3, voffB); PG8_STAGE(PG8_SB(1, 1), b3 + hstepB, voffB); PG8_STAGE(PG8_SA(1, 0), a3, voffA); PG8_SCHED; PG8_LDA(At, 1, 1);
            PG8_WAIT_V(8); PG8_WAIT_L(0); PG8_BAR; PG8_MMA(1, 0, At, B0); PG8_MMA(1, 1, At, B1); PG8_BAR; PG8_SCHED;
        }
        if (wr == 0) PG8_BAR;
        E(acc, cur, wr, wc, fr, fq);
        if (!has_next) break;
#pragma unroll
        for (int a = 0; a < 2; ++a)
#pragma unroll
            for (int b = 0; b < 2; ++b)
#pragma unroll
                for (int m = 0; m < 4; ++m)
#pragma unroll
                    for (int n = 0; n < 2; ++n) acc[a][b][m][n] = (f32x4){0.f, 0.f, 0.f, 0.f};
        cur = nxt; cA = nA; cB = nB; ++ui;
        if (wr == 1) PG8_BAR;
    }
    PG8_WAIT_V(0);
    PG8_BAR;
#undef PG8_SA
#undef PG8_SB
#undef PG8_STAGE
#undef PG8_LDA
#undef PG8_LDB
#undef PG8_MMA
#undef PG8_WAIT_V
#undef PG8_WAIT_L
#undef PG8_BAR
#undef PG8_SCHED
}
}

struct Args {
    const float* x; const int* pos; const float* g_pre; const float* w_in; const float* conv_w; const float* conv_b;
    const float* w_rg_a; const float* b_rg_a; const float* w_rg_x; const float* b_rg_x; const float* lam; const float* sinks;
    const float* w_rnn; const float* w_attn; const float* w_out; const float* g_post; const float* g_mlp_pre;
    const float* w_up; const float* w_down; const float* g_mlp_post;
    float* out; unsigned char* ws;
};

__device__ __forceinline__ void p0_transpose_item(const float* W, int K, int N, bf16_t* WT, LAS float* scr, int item, int lane, float scale = 1.0f) {
    const int nblk = N / 32, kb = item / nblk, nb = item % nblk, k0 = 64 * kb, n0 = 32 * nb;
    float tv[32];
#pragma unroll
    for (int i = 0; i < 32; ++i) tv[i] = W[(size_t)(k0 + 2 * i + (lane >> 5)) * N + n0 + (lane & 31)];
#pragma unroll
    for (int i = 0; i < 32; ++i) scr[(2 * i + (lane >> 5)) * 33 + (lane & 31)] = tv[i] * scale;
    asm volatile("s_waitcnt lgkmcnt(0)" ::: "memory");
    const int c = lane & 7;
#pragma unroll
    for (int j = 0; j < 4; ++j) { const int n = (lane >> 3) + 8 * j; const LAS float* s = scr + (8 * c) * 33 + n;
        u32x4 o; o.x = cvt_pk_bf16(s[0 * 33], s[1 * 33]); o.y = cvt_pk_bf16(s[2 * 33], s[3 * 33]); o.z = cvt_pk_bf16(s[4 * 33], s[5 * 33]); o.w = cvt_pk_bf16(s[6 * 33], s[7 * 33]);
        *(u32x4*)(WT + (size_t)(n0 + n) * K + k0 + 8 * c) = o; }
    asm volatile("s_waitcnt lgkmcnt(0)" ::: "memory");
}

__device__ __forceinline__ void rms_row_to_bf16(const float* xrow, const float* g, bf16_t* orow, int lane) {
    const f32x4* xr = (const f32x4*)xrow + lane; const f32x4* gr = (const f32x4*)g + lane;
    f32x4 v[8]; float s = 0.f;
#pragma unroll
    for (int j = 0; j < 8; ++j) { v[j] = xr[64 * j]; s += (v[j].x * v[j].x + v[j].y * v[j].y) + (v[j].z * v[j].z + v[j].w * v[j].w); }
    const float rstd = 1.0f / sqrtf(wave_sum(s) * (1.f / D_MODEL) + RMS_EPS);
    u32x2* o8 = (u32x2*)orow + lane;
#pragma unroll
    for (int j = 0; j < 8; ++j) { const f32x4 gg = gr[64 * j]; u32x2 w; w.x = cvt_pk_bf16(v[j].x * rstd * gg.x, v[j].y * rstd * gg.y); w.y = cvt_pk_bf16(v[j].z * rstd * gg.z, v[j].w * rstd * gg.w); o8[64 * j] = w; }
}

constexpr int XC_LD = 264;
constexpr int XC_BYTES = 128 * XC_LD * 2;
__device__ __forceinline__ void rnn_tile(const Args& a, LAS unsigned char* lds, int tile, int nblk) {
    int tid_ = threadIdx.x; asm volatile("" : "+v"(tid_));
    const int tid = tid_, lane = tid & 63, w = __builtin_amdgcn_readfirstlane(tid >> 6), hi = lane >> 5, l32 = lane & 31;
    bf16_t* proj = (bf16_t*)(a.ws + WS_P);
    bf16_t* qbuf = (bf16_t*)a.out;
    LAS bf16_t* xc = (LAS bf16_t*)lds;
    LAS bf16_t* yg = (LAS bf16_t*)(lds + XC_BYTES);
    LAS unsigned* rmask = (LAS unsigned*)(lds + 2 * XC_BYTES);
    const int tok0 = tile * 128, sidx0 = (tile & 63) * 128;
#pragma unroll
    for (int i = 0; i < 8; ++i) { const int p = tid + 512 * i, row = p >> 5, c16 = p & 31;
        *(LAS u32x4*)(yg + row * XC_LD + c16 * 8) = *(const u32x4*)(proj + (size_t)(tok0 + row) * D_IN + OFF_YR + nblk * 256 + c16 * 8); }
    {
        const int cgp = tid & 31, ts = tid >> 5, ch = nblk * 256 + cgp * 8;
        float wk[4][8], bb[8];
#pragma unroll
        for (int k = 0; k < 4; ++k) { const f32x4 w0 = *(const f32x4*)(a.conv_w + k * D_RNN + ch), w1 = *(const f32x4*)(a.conv_w + k * D_RNN + ch + 4);
            wk[k][0] = w0.x; wk[k][1] = w0.y; wk[k][2] = w0.z; wk[k][3] = w0.w; wk[k][4] = w1.x; wk[k][5] = w1.y; wk[k][6] = w1.z; wk[k][7] = w1.w; }
        { const f32x4 b0 = *(const f32x4*)(a.conv_b + ch), b1 = *(const f32x4*)(a.conv_b + ch + 4); bb[0] = b0.x; bb[1] = b0.y; bb[2] = b0.z; bb[3] = b0.w; bb[4] = b1.x; bb[5] = b1.y; bb[6] = b1.z; bb[7] = b1.w; }
        u32x4 raw[11];
#pragma unroll
        for (int j = 0; j < 11; ++j) { const int tl = ts * 8 + j - 3;
            if (sidx0 + tl >= 0) raw[j] = *(const u32x4*)(proj + (size_t)(tok0 + tl) * D_IN + OFF_XR + ch); else raw[j] = (u32x4){0u, 0u, 0u, 0u}; }
#pragma unroll
        for (int j = 0; j < 8; ++j) { float y[8];
#pragma unroll
            for (int e = 0; e < 8; ++e) y[e] = bb[e];
#pragma unroll
            for (int k = 0; k < 4; ++k) { const u32x4 r = raw[j + k];
                y[0] += wk[k][0] * bflo(r.x); y[1] += wk[k][1] * bfhi(r.x); y[2] += wk[k][2] * bflo(r.y); y[3] += wk[k][3] * bfhi(r.y);
                y[4] += wk[k][4] * bflo(r.z); y[5] += wk[k][5] * bfhi(r.z); y[6] += wk[k][6] * bflo(r.w); y[7] += wk[k][7] * bfhi(r.w); }
            u32x4 o; o.x = cvt_pk_bf16(y[0], y[1]); o.y = cvt_pk_bf16(y[2], y[3]); o.z = cvt_pk_bf16(y[4], y[5]); o.w = cvt_pk_bf16(y[6], y[7]);
            *(LAS u32x4*)(xc + (ts * 8 + j) * XC_LD + cgp * 8) = o; }
        if (tid < 128) { const bool z = (a.pos[tok0 + tid] == 0); const unsigned long long bal = __ballot(z); if (lane == 0) { rmask[2 * w] = (unsigned)bal; rmask[2 * w + 1] = (unsigned)(bal >> 32); } }
    }
    __syncthreads();
    const int cl = w * 32 + l32, c = nblk * 256 + cl;
    const bf16_t* wa = (const bf16_t*)(a.ws + WS_WRGA) + ((size_t)((nblk * 8 + w) * 16) * 64 + lane) * 8;
    const bf16_t* wx = (const bf16_t*)(a.ws + WS_WRGX) + ((size_t)((nblk * 8 + w) * 16) * 64 + lane) * 8;
    const float bav = -LOG2E * a.b_rg_a[c], bxv = -LOG2E * a.b_rg_x[c];
    f32x16 ga[4], gx[4];
#pragma unroll
    for (int mb = 0; mb < 4; ++mb)
#pragma unroll
        for (int i = 0; i < 16; ++i) { ga[mb][i] = bav; gx[mb][i] = bxv; }
    bf16x8 fa[4], fx[4];
#pragma unroll
    for (int p = 0; p < 3; ++p) { fa[p] = *(const bf16x8*)(wa + 512 * p); fx[p] = *(const bf16x8*)(wx + 512 * p); }
#pragma unroll
    for (int kk = 0; kk < 16; ++kk) {
        if (kk + 3 < 16) { fa[(kk + 3) & 3] = *(const bf16x8*)(wa + 512 * (kk + 3)); fx[(kk + 3) & 3] = *(const bf16x8*)(wx + 512 * (kk + 3)); }
#pragma unroll
        for (int mb = 0; mb < 4; ++mb) {
            const bf16x8 af = *(const LAS bf16x8*)(xc + (32 * mb + l32) * XC_LD + 16 * kk + 8 * hi);
            ga[mb] = __builtin_amdgcn_mfma_f32_32x32x16_bf16(af, fa[kk & 3], ga[mb], 0, 0, 0);
            gx[mb] = __builtin_amdgcn_mfma_f32_32x32x16_bf16(af, fx[kk & 3], gx[mb], 0, 0, 0);
        }
    }
    const float nsp = -8.0f * LOG2E * log1pf(expf(-a.lam[c]));
    float H = 0.f, C = 1.f;
#pragma unroll
    for (int mb = 0; mb < 4; ++mb) {
        const unsigned mw = (unsigned)__builtin_amdgcn_readfirstlane((int)rmask[mb]);
        float av[16], bv[16];
#pragma unroll
        for (int i = 0; i < 16; ++i) {
            const int row = 8 * (i >> 2) + 4 * hi + (i & 3);
            const float r = __builtin_amdgcn_rcpf(1.0f + __builtin_amdgcn_exp2f(ga[mb][i])), ig = __builtin_amdgcn_rcpf(1.0f + __builtin_amdgcn_exp2f(gx[mb][i]));
            const float aa = __builtin_amdgcn_exp2f(nsp * r);
            const float mult = __builtin_amdgcn_sqrtf(fmaf(-aa, aa, 1.0f));
            const float xv = bf2f(xc[(32 * mb + row) * XC_LD + cl]);
            av[i] = aa; bv[i] = mult * ig * xv;
        }
        if (mw != 0u) {
#pragma unroll
            for (int i = 0; i < 16; ++i) { const int row = 8 * (i >> 2) + 4 * hi + (i & 3);
                if ((mw >> row) & 1u) { const float ig = __builtin_amdgcn_rcpf(1.0f + __builtin_amdgcn_exp2f(gx[mb][i])); av[i] = 0.f; bv[i] = ig * bf2f(xc[(32 * mb + row) * XC_LD + cl]); } }
        }
#pragma unroll
        for (int g = 0; g < 4; ++g) {
            const float As = (av[4 * g] * av[4 * g + 1]) * (av[4 * g + 2] * av[4 * g + 3]);
            const float Bs = ((bv[4 * g] * av[4 * g + 1] + bv[4 * g + 1]) * av[4 * g + 2] + bv[4 * g + 2]) * av[4 * g + 3] + bv[4 * g + 3];
            const float Ao = __shfl_xor(As, 32), Bo = __shfl_xor(Bs, 32);
            const float Alo = hi ? Ao : As, Blo = hi ? Bo : Bs, Ahi = hi ? As : Ao, Bhi = hi ? Bs : Bo;
            float hs = hi ? (H * Alo + Blo) : H, cs = hi ? (C * Alo) : C;
#pragma unroll
            for (int j = 0; j < 4; ++j) { hs = av[4 * g + j] * hs + bv[4 * g + j]; cs *= av[4 * g + j];
                const int li = (32 * mb + 8 * g + 4 * hi + j) * XC_LD + cl;
                const float gy = bf2f(yg[li]);
                xc[li] = (bf16_t)(cvt_pk_bf16(hs * gy, 0.f) & 0xffffu); yg[li] = (bf16_t)(cvt_pk_bf16(cs * gy, 0.f) & 0xffffu); }
            H = (H * Alo + Blo) * Ahi + Bhi; C *= Alo * Ahi;
        }
    }
    if (hi == 0) { ((float*)(a.ws + WS_SUMA))[(size_t)tile * D_RNN + c] = C; ((float*)(a.ws + WS_SUMB))[(size_t)tile * D_RNN + c] = H; }
    __syncthreads();
#pragma unroll
    for (int i = 0; i < 8; ++i) { const int p = tid + 512 * i, row = p >> 5, c16 = p & 31;
        *(u32x4*)(proj + (size_t)(tok0 + row) * D_IN + OFF_YR + nblk * 256 + c16 * 8) = *(const LAS u32x4*)(xc + row * XC_LD + c16 * 8);
        *(u32x4*)(qbuf + (size_t)(tok0 + row) * D_RNN + nblk * 256 + c16 * 8) = *(const LAS u32x4*)(yg + row * XC_LD + c16 * 8); }
    __syncthreads();
}
__device__ __forceinline__ void rnn_fixup(const Args& a, int bx, int G) {
    bf16_t* proj = (bf16_t*)(a.ws + WS_P); const bf16_t* qbuf = (const bf16_t*)a.out; const float* hin = (const float*)(a.ws + WS_HIN);
    int tid_ = threadIdx.x; asm volatile("" : "+v"(tid_));
    for (int idx = bx * 512 + tid_; idx < M_TOK * 256; idx += G * 512) {
        const int row = idx >> 8, c8 = (idx & 255) * 8, tile = row >> 7;
        bf16_t* pp = proj + (size_t)row * D_IN + OFF_YR + c8;
        const u32x4 p = *(const u32x4*)pp, q = *(const u32x4*)(qbuf + (size_t)row * D_RNN + c8);
        const f32x4 h0 = *(const f32x4*)(hin + (size_t)tile * D_RNN + c8), h1 = *(const f32x4*)(hin + (size_t)tile * D_RNN + c8 + 4);
        u32x4 o;
        o.x = cvt_pk_bf16(bflo(p.x) + bflo(q.x) * h0.x, bfhi(p.x) + bfhi(q.x) * h0.y); o.y = cvt_pk_bf16(bflo(p.y) + bflo(q.y) * h0.z, bfhi(p.y) + bfhi(q.y) * h0.w);
        o.z = cvt_pk_bf16(bflo(p.z) + bflo(q.z) * h1.x, bfhi(p.z) + bfhi(q.z) * h1.y); o.w = cvt_pk_bf16(bflo(p.w) + bflo(q.w) * h1.z, bfhi(p.w) + bfhi(q.w) * h1.w);
        *(u32x4*)pp = o;
    }
}

constexpr int KS_LD = 72, VT_LD = 264, VT_OFF = 256 * KS_LD * 2;
constexpr int TAB_LDB = 144, TC_OFF = VT_OFF + 64 * VT_LD * 2, TS_OFF = TC_OFF + 128 * TAB_LDB, ST_OFF = TS_OFF + 128 * TAB_LDB, ST_LDB = 144, ST_WAVE = 32 * ST_LDB;
static_assert(ST_OFF + 8 * ST_WAVE <= LDS_BYTES, "attention LDS map");
__device__ __forceinline__ void attn_item(const Args& a, LAS unsigned char* lds, int item) {
    int tid_ = threadIdx.x; asm volatile("" : "+v"(tid_));
    const int tid = tid_, lane = tid & 63, w = __builtin_amdgcn_readfirstlane(tid >> 6), hi = lane >> 5, l32 = lane & 31;
    const int b = item >> 8, nb = (item >> 2) & 63, hk = item & 3;
    bf16_t* proj = (bf16_t*)(a.ws + WS_P);
    const float* tcos = (const float*)(a.ws + WS_COS); const float* tsin = (const float*)(a.ws + WS_SIN);
    LAS bf16_t* Ks = (LAS bf16_t*)lds; LAS bf16_t* Vt = (LAS bf16_t*)(lds + VT_OFF);
    const int tok0 = b * SEQ + nb * 128;
    const int hq = hk * 8 + w;
    const float sink2 = a.sinks[hq] * LOG2E;
    const float CS = 0.125f * LOG2E;
    u32x4 qraw[4];
    LAS unsigned char* stage = lds + ST_OFF + w * ST_WAVE;
    const int st_rw = ((lane >> 3) * ST_LDB) + (lane & 7) * 16;
#define ATT_LOADQ(QQ) do { const bf16_t* qp_ = proj + (size_t)(tok0 + 32 * (QQ) + (lane >> 3)) * D_IN + OFF_Q + hq * 64 + 8 * (lane & 7); \
        _Pragma("unroll") for (int it = 0; it < 4; ++it) qraw[it] = *(const u32x4*)(qp_ + (size_t)(8 * it) * D_IN); } while (0)
    ATT_LOADQ(0);
    {
        const int key = tid >> 1, part = tid & 1;
        if (nb == 0 && key < 128) {
            const u32x4 z = (u32x4){0u, 0u, 0u, 0u};
            *(LAS u32x4*)(Ks + key * KS_LD + 16 * part) = z; *(LAS u32x4*)(Ks + key * KS_LD + 16 * part + 8) = z;
            *(LAS u32x4*)(Ks + key * KS_LD + 32 + 16 * part) = z; *(LAS u32x4*)(Ks + key * KS_LD + 32 + 16 * part + 8) = z;
#pragma unroll
            for (int e = 0; e < 32; ++e) Vt[(32 * part + e) * VT_LD + key] = 0;
        } else {
            const int tok = tok0 - 128 + key;
            const bf16_t* ksrc = proj + (size_t)tok * D_IN + OFF_K + hk * 64 + 16 * part;
            const u32x4 x1a = *(const u32x4*)(ksrc), x1b = *(const u32x4*)(ksrc + 8), x2a = *(const u32x4*)(ksrc + 32), x2b = *(const u32x4*)(ksrc + 40);
            float x1[16], x2[16], cs[16], sn[16];
            x1[0] = bflo(x1a.x); x1[1] = bfhi(x1a.x); x1[2] = bflo(x1a.y); x1[3] = bfhi(x1a.y); x1[4] = bflo(x1a.z); x1[5] = bfhi(x1a.z); x1[6] = bflo(x1a.w); x1[7] = bfhi(x1a.w);
            x1[8] = bflo(x1b.x); x1[9] = bfhi(x1b.x); x1[10] = bflo(x1b.y); x1[11] = bfhi(x1b.y); x1[12] = bflo(x1b.z); x1[13] = bfhi(x1b.z); x1[14] = bflo(x1b.w); x1[15] = bfhi(x1b.w);
            x2[0] = bflo(x2a.x); x2[1] = bfhi(x2a.x); x2[2] = bflo(x2a.y); x2[3] = bfhi(x2a.y); x2[4] = bflo(x2a.z); x2[5] = bfhi(x2a.z); x2[6] = bflo(x2a.w); x2[7] = bfhi(x2a.w);
            x2[8] = bflo(x2b.x); x2[9] = bfhi(x2b.x); x2[10] = bflo(x2b.y); x2[11] = bfhi(x2b.y); x2[12] = bflo(x2b.z); x2[13] = bfhi(x2b.z); x2[14] = bflo(x2b.w); x2[15] = bfhi(x2b.w);
#pragma unroll
            for (int q4 = 0; q4 < 4; ++q4) { const f32x4 cv = *(const f32x4*)(tcos + (size_t)tok * 32 + 16 * part + 4 * q4), sv = *(const f32x4*)(tsin + (size_t)tok * 32 + 16 * part + 4 * q4);
                cs[4 * q4] = cv.x; cs[4 * q4 + 1] = cv.y; cs[4 * q4 + 2] = cv.z; cs[4 * q4 + 3] = cv.w; sn[4 * q4] = sv.x; sn[4 * q4 + 1] = sv.y; sn[4 * q4 + 2] = sv.z; sn[4 * q4 + 3] = sv.w; }
            float o1[16], o2[16];
#pragma unroll
            for (int e = 0; e < 16; ++e) { o1[e] = x1[e] * cs[e] - x2[e] * sn[e]; o2[e] = x2[e] * cs[e] + x1[e] * sn[e]; }
            u32x4 wv;
            wv.x = cvt_pk_bf16(o1[0], o1[1]); wv.y = cvt_pk_bf16(o1[2], o1[3]); wv.z = cvt_pk_bf16(o1[4], o1[5]); wv.w = cvt_pk_bf16(o1[6], o1[7]); *(LAS u32x4*)(Ks + key * KS_LD + 16 * part) = wv;
            wv.x = cvt_pk_bf16(o1[8], o1[9]); wv.y = cvt_pk_bf16(o1[10], o1[11]); wv.z = cvt_pk_bf16(o1[12], o1[13]); wv.w = cvt_pk_bf16(o1[14], o1[15]); *(LAS u32x4*)(Ks + key * KS_LD + 16 * part + 8) = wv;
            wv.x = cvt_pk_bf16(o2[0], o2[1]); wv.y = cvt_pk_bf16(o2[2], o2[3]); wv.z = cvt_pk_bf16(o2[4], o2[5]); wv.w = cvt_pk_bf16(o2[6], o2[7]); *(LAS u32x4*)(Ks + key * KS_LD + 32 + 16 * part) = wv;
            wv.x = cvt_pk_bf16(o2[8], o2[9]); wv.y = cvt_pk_bf16(o2[10], o2[11]); wv.z = cvt_pk_bf16(o2[12], o2[13]); wv.w = cvt_pk_bf16(o2[14], o2[15]); *(LAS u32x4*)(Ks + key * KS_LD + 32 + 16 * part + 8) = wv;
            const bf16_t* vsrc = proj + (size_t)tok * D_IN + OFF_V + hk * 64 + 32 * part;
#pragma unroll
            for (int q4 = 0; q4 < 4; ++q4) { const u32x4 vv = *(const u32x4*)(vsrc + 8 * q4); LAS bf16_t* vd = Vt + (32 * part + 8 * q4) * VT_LD + key;
                vd[0 * VT_LD] = (bf16_t)(vv.x & 0xffffu); vd[1 * VT_LD] = (bf16_t)(vv.x >> 16); vd[2 * VT_LD] = (bf16_t)(vv.y & 0xffffu); vd[3 * VT_LD] = (bf16_t)(vv.y >> 16);
                vd[4 * VT_LD] = (bf16_t)(vv.z & 0xffffu); vd[5 * VT_LD] = (bf16_t)(vv.z >> 16); vd[6 * VT_LD] = (bf16_t)(vv.w & 0xffffu); vd[7 * VT_LD] = (bf16_t)(vv.w >> 16); }
        }
    }
#pragma unroll
    for (int i = 0; i < 2; ++i) { const int idx = tid + 512 * i, tk = idx >> 3, f4 = idx & 7;
        *(LAS f32x4*)(lds + TC_OFF + tk * TAB_LDB + f4 * 16) = *(const f32x4*)(tcos + (size_t)tok0 * 32 + idx * 4);
        *(LAS f32x4*)(lds + TS_OFF + tk * TAB_LDB + f4 * 16) = *(const f32x4*)(tsin + (size_t)tok0 * 32 + idx * 4); }
    __syncthreads();
#pragma unroll 1
    for (int qq = 0; qq < 4; ++qq) {
        bf16_t* obase = (bf16_t*)(a.ws + WS_H) + (size_t)(tok0 + 32 * qq + (lane >> 3)) * 2048 + hq * 64 + 8 * (lane & 7);
        bf16x8 qf[4];
#pragma unroll
        for (int it = 0; it < 4; ++it) *(LAS u32x4*)(stage + st_rw + it * 8 * ST_LDB) = qraw[it];
        u32x4 qfr[4]; f32x4 qc[4], qs[4];
#pragma unroll
        for (int dd = 0; dd < 4; ++dd) qfr[dd] = *(const LAS u32x4*)(stage + l32 * ST_LDB + (16 * dd + 8 * hi) * 2);
#pragma unroll
        for (int d2 = 0; d2 < 2; ++d2) { const int to = (32 * qq + l32) * TAB_LDB + (16 * d2 + 8 * hi) * 4;
            qc[2 * d2] = *(const LAS f32x4*)(lds + TC_OFF + to); qc[2 * d2 + 1] = *(const LAS f32x4*)(lds + TC_OFF + to + 16);
            qs[2 * d2] = *(const LAS f32x4*)(lds + TS_OFF + to); qs[2 * d2 + 1] = *(const LAS f32x4*)(lds + TS_OFF + to + 16); }
#pragma unroll
        for (int d2 = 0; d2 < 2; ++d2) {
            const f32x4 c0 = qc[2 * d2], c1 = qc[2 * d2 + 1], s0 = qs[2 * d2], s1 = qs[2 * d2 + 1];
            const float cs[8] = {c0.x, c0.y, c0.z, c0.w, c1.x, c1.y, c1.z, c1.w}, sn[8] = {s0.x, s0.y, s0.z, s0.w, s1.x, s1.y, s1.z, s1.w};
            const u32x4 r1 = qfr[d2], r2 = qfr[d2 + 2];
            const float x1[8] = {bflo(r1.x), bfhi(r1.x), bflo(r1.y), bfhi(r1.y), bflo(r1.z), bfhi(r1.z), bflo(r1.w), bfhi(r1.w)};
            const float x2[8] = {bflo(r2.x), bfhi(r2.x), bflo(r2.y), bfhi(r2.y), bflo(r2.z), bfhi(r2.z), bflo(r2.w), bfhi(r2.w)};
            float o1[8], o2[8];
#pragma unroll
            for (int e = 0; e < 8; ++e) { o1[e] = x1[e] * cs[e] - x2[e] * sn[e]; o2[e] = x2[e] * cs[e] + x1[e] * sn[e]; }
            u32x4 w1, w2;
            w1.x = cvt_pk_bf16(o1[0], o1[1]); w1.y = cvt_pk_bf16(o1[2], o1[3]); w1.z = cvt_pk_bf16(o1[4], o1[5]); w1.w = cvt_pk_bf16(o1[6], o1[7]);
            w2.x = cvt_pk_bf16(o2[0], o2[1]); w2.y = cvt_pk_bf16(o2[2], o2[3]); w2.z = cvt_pk_bf16(o2[4], o2[5]); w2.w = cvt_pk_bf16(o2[6], o2[7]);
            qf[d2] = __builtin_bit_cast(bf16x8, w1); qf[d2 + 2] = __builtin_bit_cast(bf16x8, w2);
        }
        if (qq < 3) ATT_LOADQ(qq + 1);
        f32x16 s[5];
#pragma unroll
        for (int kbi = 0; kbi < 5; ++kbi) {
#pragma unroll
            for (int i = 0; i < 16; ++i) s[kbi][i] = 0.f;
            const LAS bf16_t* kp = Ks + (32 * (qq + kbi) + l32) * KS_LD + 8 * hi;
#pragma unroll
            for (int dd = 0; dd < 4; ++dd) { const bf16x8 kf = *(const LAS bf16x8*)(kp + 16 * dd); s[kbi] = __builtin_amdgcn_mfma_f32_32x32x16_bf16(kf, qf[dd], s[kbi], 0, 0, 0); }
        }
        if (nb == 0) {
#pragma unroll
            for (int kbi = 0; kbi < 4; ++kbi) if (qq + kbi < 4) {
#pragma unroll
                for (int i = 0; i < 16; ++i) s[kbi][i] = -1e30f; }
        }
        const int tq = l32 - 4 * hi;
#pragma unroll
        for (int i = 0; i < 16; ++i) { const int rr = 8 * (i >> 2) + (i & 3); s[0][i] = (rr > tq) ? s[0][i] : -1e30f; s[4][i] = (rr <= tq) ? s[4][i] : -1e30f; }
        float mx = -1e30f;
#pragma unroll
        for (int kbi = 0; kbi < 5; ++kbi)
#pragma unroll
            for (int i = 0; i < 16; i += 2) mx = fmaxf(mx, fmaxf(s[kbi][i], s[kbi][i + 1]));
        mx = fmaxf(mx, __shfl_xor(mx, 32)); mx = fmaxf(mx * CS, sink2);
        const float nmx = -mx;
        float lsum = 0.f;
        bf16x8 pk[5][2];
#pragma unroll
        for (int kbi = 0; kbi < 5; ++kbi) {
#pragma unroll
            for (int i = 0; i < 16; ++i) { const float p = __builtin_amdgcn_exp2f(fmaf(s[kbi][i], CS, nmx)); s[kbi][i] = p; lsum += p; }
#pragma unroll
            for (int j2 = 0; j2 < 2; ++j2) { u32x4 pw;
                pw.x = cvt_pk_bf16(s[kbi][8 * j2 + 0], s[kbi][8 * j2 + 1]); pw.y = cvt_pk_bf16(s[kbi][8 * j2 + 2], s[kbi][8 * j2 + 3]);
                pw.z = cvt_pk_bf16(s[kbi][8 * j2 + 4], s[kbi][8 * j2 + 5]); pw.w = cvt_pk_bf16(s[kbi][8 * j2 + 6], s[kbi][8 * j2 + 7]);
                pk[kbi][j2] = __builtin_bit_cast(bf16x8, pw); }
        }
        lsum += __shfl_xor(lsum, 32); lsum += __builtin_amdgcn_exp2f(sink2 - mx);
        const float inv = 1.0f / lsum;
        f32x16 o[2];
#pragma unroll
        for (int db = 0; db < 2; ++db)
#pragma unroll
            for (int i = 0; i < 16; ++i) o[db][i] = 0.f;
#pragma unroll
        for (int kbi = 0; kbi < 5; ++kbi)
#pragma unroll
            for (int j2 = 0; j2 < 2; ++j2)
#pragma unroll
                for (int db = 0; db < 2; ++db) {
                    const LAS bf16_t* vp = Vt + (32 * db + l32) * VT_LD + 32 * (qq + kbi) + 16 * j2 + 4 * hi;
                    const s16x4 lo = *(const LAS s16x4*)vp, hh = *(const LAS s16x4*)(vp + 8);
                    const bf16x8 vf = (bf16x8){lo[0], lo[1], lo[2], lo[3], hh[0], hh[1], hh[2], hh[3]};
                    o[db] = __builtin_amdgcn_mfma_f32_32x32x16_bf16(vf, pk[kbi][j2], o[db], 0, 0, 0);
                }
#pragma unroll
        for (int db = 0; db < 2; ++db)
#pragma unroll
            for (int g = 0; g < 4; ++g) { u32x2 wv; wv.x = cvt_pk_bf16(o[db][4 * g] * inv, o[db][4 * g + 1] * inv); wv.y = cvt_pk_bf16(o[db][4 * g + 2] * inv, o[db][4 * g + 3] * inv);
                *(LAS u32x2*)(stage + l32 * ST_LDB + (32 * db + 8 * g + 4 * hi) * 2) = wv; }
#pragma unroll
        for (int it = 0; it < 4; ++it) { const u32x4 ov = *(const LAS u32x4*)(stage + st_rw + it * 8 * ST_LDB); *(u32x4*)(obase + (size_t)(8 * it) * 2048) = ov; }
    }
    __syncthreads();
#undef ATT_LOADQ
}

#define XB_TMO      128
#define XB_XCNT(j)  (256  + 64 * (j))
#define XB_XSUB(j)  (1280 + 64 * (j))
#define XB_XGEN(j)  (2304 + 64 * (j))
#define XB_TOP      3328
#define XB_TOPGEN   3392
#define XCD_BAR_WORDS 3456
#define XB_SPIN_CAP (1u << 18)

__device__ __forceinline__ unsigned xb_ld(unsigned* p)              { return __hip_atomic_load(p, __ATOMIC_RELAXED, __HIP_MEMORY_SCOPE_AGENT); }
__device__ __forceinline__ unsigned xb_add(unsigned* p, unsigned v) { return __hip_atomic_fetch_add(p, v, __ATOMIC_RELAXED, __HIP_MEMORY_SCOPE_AGENT); }
__device__ __forceinline__ unsigned xb_xcc_id() { return (unsigned)__builtin_amdgcn_s_getreg((3 << 11) | 20) & 0xFu; }
#define XB_SPIN(cond, bar) do { unsigned _sp = 0; while (cond) { __builtin_amdgcn_s_sleep(1); \
    if ((++_sp & 255u) == 0u) { if (xb_ld(&(bar)[XB_TMO])) break; if (_sp > XB_SPIN_CAP) { atomicAdd(&(bar)[XB_TMO], 1u); break; } } } } while (0)

struct XcdBarrier {
    unsigned* bar; unsigned x;
    volatile LAS unsigned* st;
};

__device__ __forceinline__ XcdBarrier xcd_barrier_post(unsigned* bar, volatile LAS unsigned* st) {
    XcdBarrier b; b.bar = bar; b.x = xb_xcc_id(); b.st = st;
    if (threadIdx.x == 0) (void)xb_add(&bar[XB_XCNT(b.x)], 1u);
    return b;
}
__device__ __forceinline__ void xcd_barrier_complete(unsigned* bar, unsigned x, unsigned& nloc, unsigned& nx) {
    const unsigned G = gridDim.x * gridDim.y * gridDim.z;
    unsigned sum, cnt, mine, sp = 0u;
    for (;;) {
        sum = 0u; cnt = 0u; mine = 0u;
#pragma unroll
        for (unsigned j = 0; j < 16; ++j) { const unsigned c = xb_ld(&bar[XB_XCNT(j)]); sum += c; cnt += (c > 0u) ? 1u : 0u; mine = (j == x) ? c : mine; }
        if (sum == G) break;
        __builtin_amdgcn_s_sleep(1);
        if ((++sp & 255u) == 0u) { if (xb_ld(&bar[XB_TMO])) break; if (sp > XB_SPIN_CAP) { atomicAdd(&bar[XB_TMO], 1u); break; } }
    }
    nloc = mine > 0u ? mine : 1u; nx = cnt > 0u ? cnt : 1u;
}

__device__ __forceinline__ void xcd_barrier(const XcdBarrier& b) {
    asm volatile("s_waitcnt vmcnt(0)" ::: "memory");
    __syncthreads();
    if (threadIdx.x == 0) {
        unsigned* bar = b.bar;
        __builtin_amdgcn_s_waitcnt(0);
        unsigned nloc = b.st[0], nx = b.st[1];
        if (nloc == 0u) { xcd_barrier_complete(bar, b.x, nloc, nx); b.st[0] = nloc; b.st[1] = nx; }
        const unsigned old = xb_add(&bar[XB_XSUB(b.x)], 1u);
        const unsigned gen = old / nloc;
        if (old + 1u == (gen + 1u) * nloc) {
            __builtin_amdgcn_fence(__ATOMIC_RELEASE, "agent");
            asm volatile("s_waitcnt vmcnt(0)" ::: "memory");
            const unsigned og = xb_add(&bar[XB_TOP], 1u);
            const unsigned tg = og / nx;
            if (og + 1u == (tg + 1u) * nx) xb_add(&bar[XB_TOPGEN], 1u);
            else XB_SPIN(xb_ld(&bar[XB_TOPGEN]) == tg, bar);
            __builtin_amdgcn_fence(__ATOMIC_ACQUIRE, "agent");
            xb_add(&bar[XB_XGEN(b.x)], 1u);
            asm volatile("s_waitcnt vmcnt(0)" ::: "memory");
        } else {
            XB_SPIN(xb_ld(&bar[XB_XGEN(b.x)]) == gen, bar);
            __builtin_amdgcn_fence(__ATOMIC_ACQUIRE, "agent");
            asm volatile("s_waitcnt vmcnt(0)" ::: "memory");
        }
    }
    __syncthreads();
}


__device__ __forceinline__ void grid_barrier(unsigned* ctr, unsigned target) {
    asm volatile("s_waitcnt vmcnt(0) lgkmcnt(0)" ::: "memory");
    __syncthreads();
    if (threadIdx.x == 0) {
        __builtin_amdgcn_fence(__ATOMIC_RELEASE, "agent");
        asm volatile("s_waitcnt vmcnt(0)" ::: "memory");
        __hip_atomic_fetch_add(ctr, 1u, __ATOMIC_RELAXED, __HIP_MEMORY_SCOPE_AGENT);
        while (__hip_atomic_load(ctr, __ATOMIC_RELAXED, __HIP_MEMORY_SCOPE_AGENT) < target) __builtin_amdgcn_s_sleep(2);
        __builtin_amdgcn_fence(__ATOMIC_ACQUIRE, "agent");
        asm volatile("s_waitcnt vmcnt(0)" ::: "memory");
    }
    __syncthreads();
}
#define GRID_SYNC_CG() do { asm volatile("s_waitcnt vmcnt(0) lgkmcnt(0)" ::: "memory"); grid.sync(); __builtin_amdgcn_fence(__ATOMIC_ACQUIRE, "agent"); asm volatile("s_waitcnt vmcnt(0)" ::: "memory"); } while (0)
#define GRID_SYNC() xcd_barrier(xbar)
__global__ void __launch_bounds__(512, 2) fwd_megakernel(Args a) {
    extern __shared__ __attribute__((aligned(16))) unsigned char lds_raw[];
    LAS unsigned char* lds = (LAS unsigned char*)lds_raw;
    cg::grid_group grid = cg::this_grid();
    const int tid = threadIdx.x, lane = tid & 63, wave = __builtin_amdgcn_readfirstlane(tid >> 6);
    const int G = gridDim.x, bx = blockIdx.x;
    const int gw = bx * 8 + wave, NGW = G * 8;
    bf16_t* proj = (bf16_t*)(a.ws + WS_P);
    bf16_t* Hb = (bf16_t*)(a.ws + WS_H);
    volatile LAS unsigned* xst = (volatile LAS unsigned*)(lds + LDS_BYTES - 16);
    if (tid == 0) { xst[0] = 0u; xst[1] = 0u; }
    __syncthreads();
    const XcdBarrier xbar = xcd_barrier_post((unsigned*)(a.ws + WS_CTL), xst);
    if (a.ws == nullptr) GRID_SYNC_CG();

    for (int rep_ = 0; rep_ < REP_A; ++rep_) {
    {
        LAS float* scr = (LAS float*)(lds + wave * 16384);
        constexpr int I_IN = (D_MODEL / 64) * (D_IN / 32), I_SQ = (2048 / 64) * (2048 / 32), I_UP = (D_MODEL / 64) * (D_FF / 32), I_DN = (D_FF / 64) * (D_MODEL / 32);
        constexpr int NITEMS = I_IN + 3 * I_SQ + I_UP + I_DN;
        for (int it = gw; it < NITEMS; it += NGW) {
            int r = it;
            if (r < I_IN) { p0_transpose_item(a.w_in, D_MODEL, D_IN, (bf16_t*)(a.ws + WS_WIN), scr, r, lane); continue; } r -= I_IN;
            if (r < I_SQ) { p0_transpose_item(a.w_rnn, 2048, 2048, (bf16_t*)(a.ws + WS_WRNN), scr, r, lane); continue; } r -= I_SQ;
            if (r < I_SQ) { p0_transpose_item(a.w_attn, 2048, 2048, (bf16_t*)(a.ws + WS_WATT), scr, r, lane); continue; } r -= I_SQ;
            if (r < I_SQ) { p0_transpose_item(a.w_out, 2048, 2048, (bf16_t*)(a.ws + WS_WOUT), scr, r, lane); continue; } r -= I_SQ;
            if (r < I_UP) { p0_transpose_item(a.w_up, D_MODEL, D_FF, (bf16_t*)(a.ws + WS_WUP), scr, r, lane); continue; } r -= I_UP;
            p0_transpose_item(a.w_down, D_FF, D_MODEL, (bf16_t*)(a.ws + WS_WDN), scr, r, lane);
        }
        for (int v = bx * 512 + tid; v < 2 * 65536; v += G * 512) {
            const int gate = v >> 16, r = v & 65535, ln = r & 63, kk = (r >> 6) & 15, wv = (r >> 10) & 7, nb = r >> 13;
            const float* src = (gate ? a.w_rg_x : a.w_rg_a) + (size_t)nb * 65536 + (size_t)(16 * kk + 8 * (ln >> 5)) * 256 + 32 * wv + (ln & 31);
            float e[8];
#pragma unroll
            for (int q = 0; q < 8; ++q) e[q] = src[q * 256] * (-LOG2E);
            u32x4 o; o.x = cvt_pk_bf16(e[0], e[1]); o.y = cvt_pk_bf16(e[2], e[3]); o.z = cvt_pk_bf16(e[4], e[5]); o.w = cvt_pk_bf16(e[6], e[7]);
            *(u32x4*)((bf16_t*)(a.ws + (gate ? WS_WRGX : WS_WRGA)) + (size_t)r * 8) = o;
        }
        for (int m = gw; m < M_TOK; m += NGW) rms_row_to_bf16(a.x + (size_t)m * D_MODEL, a.g_pre, Hb + (size_t)m * D_MODEL, lane);
        float* tcos = (float*)(a.ws + WS_COS); float* tsin = (float*)(a.ws + WS_SIN);
        for (int i = bx * 512 + tid; i < M_TOK * 32; i += G * 512) {
            const int tok = i >> 5, f = i & 31;
            const float inv_freq = exp2f(-(float)f * (13.287712379549449f / 32.0f));
            const float ang = (float)a.pos[tok] * inv_freq;
            float sv, cv; sincosf(ang, &sv, &cv); tcos[i] = cv; tsin[i] = sv;
        }
    }
    GRID_SYNC();
    }
    for (int rep_ = 0; rep_ < REP_G; ++rep_) {
    {
        pg8::Gemm g{Hb, (const bf16_t*)(a.ws + WS_WIN), M_TOK, D_IN, D_MODEL, D_MODEL}; pg8::StaticOrder S; S.init(M_TOK, D_IN, G, bx);
        pg8::EpiBf16 E{proj, D_IN, 0};
        pg8::gemm_phase<pg8::EpiBf16>(lds, g, S, E);
    }
    GRID_SYNC();
    }
    for (int rep_ = 0; rep_ < REP_B; ++rep_) {
    for (int it = bx; it < 256 * 8; it += G) rnn_tile(a, lds, it >> 3, it & 7);
    GRID_SYNC();
    }
    for (int rep_ = 0; rep_ < REP_C; ++rep_) {
    {
        if (tid < 32) {
            const int gi = bx * 32 + tid;
            if (gi < BATCH * D_RNN) {
                const int b = gi / D_RNN, ch = gi % D_RNN;
                const float* sa = (const float*)(a.ws + WS_SUMA) + (size_t)b * 64 * D_RNN + ch; const float* sb = (const float*)(a.ws + WS_SUMB) + (size_t)b * 64 * D_RNN + ch;
                float* hin = (float*)(a.ws + WS_HIN) + (size_t)b * 64 * D_RNN + ch;
                float H = 0.f;
                for (int j0 = 0; j0 < 64; j0 += 8) {
                    float av[8], bv[8];
#pragma unroll
                    for (int j = 0; j < 8; ++j) { av[j] = sa[(size_t)(j0 + j) * D_RNN]; bv[j] = sb[(size_t)(j0 + j) * D_RNN]; }
#pragma unroll
                    for (int j = 0; j < 8; ++j) { hin[(size_t)(j0 + j) * D_RNN] = H; H = H * av[j] + bv[j]; }
                }
            }
        }
        for (int it = bx; it < 1024; it += G) attn_item(a, lds, it);
    }
    GRID_SYNC();
    }
    rnn_fixup(a, bx, G);
    GRID_SYNC();
    {
        pg8::StaticOrder S; S.init(M_TOK, D_MODEL, G, bx);
        { pg8::Gemm g{proj + OFF_YR, (const bf16_t*)(a.ws + WS_WRNN), M_TOK, D_MODEL, D_RNN, D_IN};
          pg8::EpiGate E{proj + OFF_GR, nullptr, D_IN}; pg8::gemm_phase<pg8::EpiGate>(lds, g, S, E); }
        { pg8::Gemm g{Hb, (const bf16_t*)(a.ws + WS_WATT), M_TOK, D_MODEL, 2048, 2048};
          pg8::EpiGate E{proj + OFF_GA, proj + OFF_GR, D_IN}; pg8::gemm_phase<pg8::EpiGate>(lds, g, S, E); }
    }
    GRID_SYNC();
    for (int rep_ = 0; rep_ < REP_G; ++rep_) {
    {
        pg8::Gemm g{proj + OFF_GA, (const bf16_t*)(a.ws + WS_WOUT), M_TOK, D_MODEL, D_MODEL, D_IN}; pg8::StaticOrder S; S.init(M_TOK, D_MODEL, G, bx);
        pg8::EpiBf16 E{Hb, D_MODEL, 4}; pg8::gemm_phase<pg8::EpiBf16>(lds, g, S, E);
    }
    GRID_SYNC();
    }
    for (int m = gw; m < M_TOK; m += NGW) {
        const f32x4* xr = (const f32x4*)(a.x + (size_t)m * D_MODEL) + lane;
        const u32x2* tb = (const u32x2*)(Hb + (size_t)m * D_MODEL) + lane; u32x2* x1w = (u32x2*)((bf16_t*)(a.ws + WS_X1) + (size_t)m * D_MODEL) + lane;
        const f32x4* g1 = (const f32x4*)a.g_post + lane; const f32x4* g2 = (const f32x4*)a.g_mlp_pre + lane;
        f32x4 v[8]; float s = 0.f;
#pragma unroll
        for (int j = 0; j < 8; ++j) { const u32x2 t2 = tb[64 * j]; v[j] = (f32x4){bflo(t2.x), bfhi(t2.x), bflo(t2.y), bfhi(t2.y)}; s += (v[j].x * v[j].x + v[j].y * v[j].y) + (v[j].z * v[j].z + v[j].w * v[j].w); }
        const float rstd = 1.0f / sqrtf(wave_sum(s) * (1.f / D_MODEL) + RMS_EPS);
        float s2 = 0.f;
#pragma unroll
        for (int j = 0; j < 8; ++j) { const f32x4 xx = xr[64 * j], gg = g1[64 * j]; v[j] = xx + v[j] * rstd * gg;
            u32x2 w1; w1.x = cvt_pk_bf16(v[j].x, v[j].y); w1.y = cvt_pk_bf16(v[j].z, v[j].w); x1w[64 * j] = w1;
            s2 += (v[j].x * v[j].x + v[j].y * v[j].y) + (v[j].z * v[j].z + v[j].w * v[j].w); }
        const float rstd2 = 1.0f / sqrtf(wave_sum(s2) * (1.f / D_MODEL) + RMS_EPS);
        u32x2* o8 = (u32x2*)(Hb + (size_t)m * D_MODEL) + lane;
#pragma unroll
        for (int j = 0; j < 8; ++j) { const f32x4 gg = g2[64 * j]; u32x2 w; w.x = cvt_pk_bf16(v[j].x * rstd2 * gg.x, v[j].y * rstd2 * gg.y); w.y = cvt_pk_bf16(v[j].z * rstd2 * gg.z, v[j].w * rstd2 * gg.w); o8[64 * j] = w; }
    }
    GRID_SYNC();
    for (int rep_ = 0; rep_ < REP_G; ++rep_) {
    {
        pg8::Gemm g{Hb, (const bf16_t*)(a.ws + WS_WUP), M_TOK, D_FF, D_MODEL, D_MODEL}; pg8::StaticOrder S; S.init(M_TOK, D_FF, G, bx);
        pg8::EpiBf16 E{(bf16_t*)(a.ws + WS_U), D_FF, 3}; pg8::gemm_phase<pg8::EpiBf16>(lds, g, S, E);
    }
    GRID_SYNC();
    }
    for (int rep_ = 0; rep_ < REP_G; ++rep_) {
    {
        pg8::Gemm g{(const bf16_t*)(a.ws + WS_U), (const bf16_t*)(a.ws + WS_WDN), M_TOK, D_MODEL, D_FF, D_FF}; pg8::StaticOrder S; S.init(M_TOK, D_MODEL, G, bx);
        pg8::EpiBf16 E{(bf16_t*)(a.ws + WS_D), D_MODEL, 4}; pg8::gemm_phase<pg8::EpiBf16>(lds, g, S, E);
    }
    GRID_SYNC();
    }
    for (int m = gw; m < M_TOK; m += NGW) {
        f32x4* orow = (f32x4*)(a.out + (size_t)m * D_MODEL) + lane; const u32x2* dr = (const u32x2*)((const bf16_t*)(a.ws + WS_D) + (size_t)m * D_MODEL) + lane;
        const f32x4* g1 = (const f32x4*)a.g_mlp_post + lane; const u32x2* x1b = (const u32x2*)((const bf16_t*)(a.ws + WS_X1) + (size_t)m * D_MODEL) + lane;
        f32x4 v[8]; float s = 0.f;
#pragma unroll
        for (int j = 0; j < 8; ++j) { const u32x2 t2 = dr[64 * j]; v[j] = (f32x4){bflo(t2.x), bfhi(t2.x), bflo(t2.y), bfhi(t2.y)}; s += (v[j].x * v[j].x + v[j].y * v[j].y) + (v[j].z * v[j].z + v[j].w * v[j].w); }
        const float rstd = 1.0f / sqrtf(wave_sum(s) * (1.f / D_MODEL) + RMS_EPS);
#pragma unroll
        for (int j = 0; j < 8; ++j) { const f32x4 gg = g1[64 * j]; const u32x2 x2 = x1b[64 * j]; const f32x4 x1 = (f32x4){bflo(x2.x), bfhi(x2.x), bflo(x2.y), bfhi(x2.y)}; orow[64 * j] = x1 + v[j] * rstd * gg; }
    }
}

extern "C" void kernel_launch(void* const* d_in, const int* in_sizes, int n_in, void* d_out, int out_size, void* d_ws, size_t ws_size, hipStream_t stream) {
    static int grid_blocks = 0;
    if (grid_blocks == 0) {
        if (n_in != 20 || in_sizes[0] != M_TOK * D_MODEL || out_size != M_TOK * D_MODEL || ws_size < WS_END) {
            fprintf(stderr, "kernel_launch: unexpected shapes: n_in %d in0 %d out %d ws %zu (need %zu)\n", n_in, n_in > 0 ? in_sizes[0] : -1, out_size, ws_size, (size_t)WS_END); grid_blocks = -1; return; }
        int dev = 0, cus = 0, per_cu = 0;
        (void)hipGetDevice(&dev);
        (void)hipDeviceGetAttribute(&cus, hipDeviceAttributeMultiprocessorCount, dev);
        if (hipFuncSetAttribute((const void*)fwd_megakernel, hipFuncAttributeMaxDynamicSharedMemorySize, LDS_BYTES) != hipSuccess) fprintf(stderr, "kernel_launch: hipFuncSetAttribute failed\n");
        if (hipOccupancyMaxActiveBlocksPerMultiprocessor(&per_cu, (const void*)fwd_megakernel, 512, LDS_BYTES) != hipSuccess || per_cu < 1) { fprintf(stderr, "kernel_launch: occupancy query gave %d\n", per_cu); per_cu = 1; }
        (void)hipGetLastError();
        grid_blocks = cus * per_cu;
    }
    if (grid_blocks < 0) return;
    Args a{};
    a.x = (const float*)d_in[0]; a.pos = (const int*)d_in[1]; a.g_pre = (const float*)d_in[2]; a.w_in = (const float*)d_in[3]; a.conv_w = (const float*)d_in[4]; a.conv_b = (const float*)d_in[5];
    a.w_rg_a = (const float*)d_in[6]; a.b_rg_a = (const float*)d_in[7]; a.w_rg_x = (const float*)d_in[8]; a.b_rg_x = (const float*)d_in[9]; a.lam = (const float*)d_in[10]; a.sinks = (const float*)d_in[11];
    a.w_rnn = (const float*)d_in[12]; a.w_attn = (const float*)d_in[13]; a.w_out = (const float*)d_in[14]; a.g_post = (const float*)d_in[15]; a.g_mlp_pre = (const float*)d_in[16];
    a.w_up = (const float*)d_in[17]; a.w_down = (const float*)d_in[18]; a.g_mlp_post = (const float*)d_in[19];
    a.out = (float*)d_out; a.ws = (unsigned char*)d_ws;
    if (hipMemsetAsync((char*)d_ws + WS_CTL, 0, 16384, stream) != hipSuccess) { fprintf(stderr, "kernel_launch: memset failed\n"); return; }
    void* args[] = {&a};
    hipError_t e = hipLaunchCooperativeKernel((const void*)fwd_megakernel, dim3(grid_blocks), dim3(512), args, LDS_BYTES, stream);
    if (e != hipSuccess) fprintf(stderr, "cooperative launch failed: %s (grid %d)\n", hipGetErrorString(e), grid_blocks);
}
```

```cpp
#include <hip/hip_runtime.h>
#include <hip/hip_cooperative_groups.h>
#include <cstdio>
#include <cstdint>
namespace cg = cooperative_groups;

#define LAS __attribute__((address_space(3)))
typedef unsigned short bf16_t;
typedef short bf16x8 __attribute__((ext_vector_type(8)));
typedef short s16x4 __attribute__((ext_vector_type(4)));
typedef float f32x4 __attribute__((ext_vector_type(4)));
typedef float f32x2 __attribute__((ext_vector_type(2)));
typedef float f32x16 __attribute__((ext_vector_type(16)));
typedef unsigned u32x4 __attribute__((ext_vector_type(4)));
typedef unsigned u32x2 __attribute__((ext_vector_type(2)));

constexpr int D_MODEL = 2048, BATCH = 4, SEQ = 8192, M_TOK = BATCH * SEQ;
constexpr int D_RNN = 2048, D_FF = 8192, D_IN = 10752;
constexpr int OFF_XR = 0, OFF_YR = 2048, OFF_Q = 4096, OFF_K = 6144, OFF_V = 6400, OFF_GR = 6656, OFF_GA = 8704;
constexpr float RMS_EPS = 1e-6f;
constexpr float LOG2E = 1.4426950408889634f;

constexpr size_t MiB = 1u << 20;
constexpr size_t WS_COS = 0, WS_SIN = 4 * MiB, WS_SUMA = 8 * MiB, WS_SUMB = 10 * MiB, WS_HIN = 12 * MiB;
constexpr size_t WS_WRGA = 14 * MiB, WS_WRGX = 15 * MiB, WS_WIN = 16 * MiB, WS_WRNN = 58 * MiB, WS_WATT = 66 * MiB, WS_WOUT = 74 * MiB;
constexpr size_t WS_WUP = 82 * MiB, WS_WDN = 114 * MiB, WS_P = 146 * MiB, WS_H = 818 * MiB, WS_U = 146 * MiB, WS_D = 818 * MiB, WS_X1 = 658 * MiB, WS_CTL = 946 * MiB, WS_END = 947 * MiB;

constexpr int LDS_BYTES = 147456;
#ifndef REP_G
#define REP_G 1
#endif
#ifndef REP_A
#define REP_A 1
#endif
#ifndef REP_B
#define REP_B 1
#endif
#ifndef REP_C
#define REP_C 1
#endif

typedef __bf16 bf16x2_t __attribute__((ext_vector_type(2)));
__device__ __forceinline__ unsigned cvt_pk_bf16(float lo, float hi) { const f32x2 v = {lo, hi}; const bf16x2_t b = __builtin_convertvector(v, bf16x2_t); return __builtin_bit_cast(unsigned, b); }
__device__ __forceinline__ float bf2f(unsigned short b) { return __uint_as_float(((unsigned)b) << 16); }
__device__ __forceinline__ float bflo(unsigned w) { return __uint_as_float(w << 16); }
__device__ __forceinline__ float bfhi(unsigned w) { return __uint_as_float(w & 0xffff0000u); }
__device__ __forceinline__ float sigmoidf_(float v) { return __builtin_amdgcn_rcpf(1.0f + __builtin_amdgcn_exp2f(-v * LOG2E)); }
__device__ __forceinline__ float gelu_tanh(float v) { const float u = 1.5957691216057308f * (v + 0.044715f * v * v * v); return v * sigmoidf_(u); }
__device__ __forceinline__ float wave_sum(float v) {
#pragma unroll
    for (int o = 1; o < 64; o <<= 1) v += __shfl_xor(v, o);
    return v;
}

namespace pg8 {
constexpr int BM = 256, BK = 64, HALF = 128, HTB = HALF * BK * 2, STAGE_BYTES = 8 * HTB, NXCD = 8, WGM = 8;
__host__ __device__ __forceinline__ int lds_byte(int r, int c) { const int st = (r >> 4) * 2 + (c >> 5), rr = r & 15, cc = c & 31, ob = rr * 64 + cc * 2; return st * 1024 + (ob ^ (((ob >> 9) & 1) << 5)); }
__host__ __device__ __forceinline__ void stage_rc(int b, int& R, int& C) { const int st = b / 1024, sb = b % 1024, swz = sb ^ (((sb >> 9) & 1) << 5); R = (st >> 1) * 16 + swz / 64; C = (st & 1) * 32 + (swz % 64) / 2; }
__host__ __device__ __forceinline__ int perm32(int rho) { const int n = rho >> 4, i = rho & 15; return 8 * (i >> 2) + 4 * n + (i & 3); }

struct Unit { int pm, pn; };
struct Gemm { const bf16_t* A; const bf16_t* Bt; int M, N, K, lda; };

struct StaticOrder {
    int nM, nN, nwg, G, c;
    __device__ void init(int M, int N, int G_, int c_) { nM = M / BM; nN = N / BM; nwg = nM * nN; G = G_; c = c_; }
    __device__ bool next(int i, Unit& u) const {
        const long L = (long)i * G + c; if (L >= nwg) return false;
        int wgid = (int)L; { const int q = nwg / NXCD, r = nwg % NXCD, xcd = wgid % NXCD, off = wgid / NXCD; wgid = (xcd < r ? xcd * (q + 1) : r * (q + 1) + (xcd - r) * q) + off; }
        const int nig = WGM * nN, gid = wgid / nig, fm = gid * WGM, gsz = (nM - fm) < WGM ? (nM - fm) : WGM;
        u.pm = fm + ((wgid % nig) % gsz); u.pn = (wgid % nig) / gsz; return true;
    }
};

struct EpiBf16 {
    static constexpr bool PERM = true;
    bf16_t* O; int ldc; int mode;
    template <int ACT> __device__ __forceinline__ void run(const f32x4 (&acc)[2][2][4][2], const Unit& u, int wr, int wc, int fr, int fq) const {
        const int row0 = u.pm * BM + wr * 64 + fr, col0 = u.pn * BM + wc * 32 + 8 * fq;
#pragma unroll
        for (int ai = 0; ai < 2; ++ai)
#pragma unroll
            for (int m = 0; m < 4; ++m) { bf16_t* rowp = O + (size_t)(row0 + ai * HALF + m * 16) * ldc + col0;
#pragma unroll
                for (int bj = 0; bj < 2; ++bj) { f32x4 v0 = acc[ai][bj][m][0], v1 = acc[ai][bj][m][1];
#pragma unroll
                    for (int e = 0; e < 4; ++e) {
                        if (ACT == 1) { v0[e] = gelu_tanh(v0[e]); v1[e] = gelu_tanh(v1[e]); }
                        if (ACT == 2) { v0[e] = sigmoidf_(v0[e]); v1[e] = sigmoidf_(v1[e]); }
                        if (ACT == 3) { const float a0 = fmaxf(v0[e], 0.f), a1 = fmaxf(v1[e], 0.f); v0[e] = a0 * a0; v1[e] = a1 * a1; }
                    }
                    u32x4 w; w.x = cvt_pk_bf16(v0[0], v0[1]); w.y = cvt_pk_bf16(v0[2], v0[3]); w.z = cvt_pk_bf16(v1[0], v1[1]); w.w = cvt_pk_bf16(v1[2], v1[3]);
                    *(u32x4*)(rowp + bj * HALF) = w; } }
    }
    __device__ __forceinline__ void operator()(const f32x4 (&acc)[2][2][4][2], const Unit& u, int wr, int wc, int fr, int fq) const {
        if (mode == 3) { run<3>(acc, u, wr, wc, fr, fq); return; }
        if (mode == 4) { run<0>(acc, u, wr, wc, fr, fq); return; }
        const int seg = u.pn;
        if (seg >= 8 && seg < 16) run<1>(acc, u, wr, wc, fr, fq);
        else if (seg >= 26) run<2>(acc, u, wr, wc, fr, fq);
        else run<0>(acc, u, wr, wc, fr, fq);
    }
};
struct EpiGate {
    static constexpr bool PERM = true;
    bf16_t* G; const bf16_t* P; int ld;
    __device__ __forceinline__ void operator()(const f32x4 (&acc)[2][2][4][2], const Unit& u, int wr, int wc, int fr, int fq) const {
        const int row0 = u.pm * BM + wr * 64 + fr, col0 = u.pn * BM + wc * 32 + 8 * fq;
#pragma unroll
        for (int ai = 0; ai < 2; ++ai)
#pragma unroll
            for (int m = 0; m < 4; ++m) { const size_t ro = (size_t)(row0 + ai * HALF + m * 16) * ld + col0;
#pragma unroll
                for (int bj = 0; bj < 2; ++bj) { const f32x4 v0 = acc[ai][bj][m][0], v1 = acc[ai][bj][m][1];
                    const u32x4 g = *(const u32x4*)(G + ro + bj * HALF);
                    float o[8];
                    o[0] = bflo(g.x) * v0[0]; o[1] = bfhi(g.x) * v0[1]; o[2] = bflo(g.y) * v0[2]; o[3] = bfhi(g.y) * v0[3];
                    o[4] = bflo(g.z) * v1[0]; o[5] = bfhi(g.z) * v1[1]; o[6] = bflo(g.w) * v1[2]; o[7] = bfhi(g.w) * v1[3];
                    if (P) { const u32x4 p = *(const u32x4*)(P + ro + bj * HALF);
                        o[0] += bflo(p.x); o[1] += bfhi(p.x); o[2] += bflo(p.y); o[3] += bfhi(p.y); o[4] += bflo(p.z); o[5] += bfhi(p.z); o[6] += bflo(p.w); o[7] += bfhi(p.w); }
                    u32x4 w; w.x = cvt_pk_bf16(o[0], o[1]); w.y = cvt_pk_bf16(o[2], o[3]); w.z = cvt_pk_bf16(o[4], o[5]); w.w = cvt_pk_bf16(o[6], o[7]);
                    *(u32x4*)(G + ro + bj * HALF) = w; } }
    }
};
struct EpiF32 {
    static constexpr bool PERM = false;
    float* O; int ldc;
    __device__ __forceinline__ void operator()(const f32x4 (&acc)[2][2][4][2], const Unit& u, int wr, int wc, int fr, int fq) const {
        const int row0 = u.pm * BM + wr * 64 + fr, col0 = u.pn * BM + wc * 32 + 4 * fq;
#pragma unroll
        for (int ai = 0; ai < 2; ++ai)
#pragma unroll
            for (int m = 0; m < 4; ++m) { float* rowp = O + (size_t)(row0 + ai * HALF + m * 16) * ldc + col0;
#pragma unroll
                for (int bj = 0; bj < 2; ++bj)
#pragma unroll
                    for (int n = 0; n < 2; ++n) *(f32x4*)(rowp + bj * HALF + n * 16) = acc[ai][bj][m][n]; }
    }
};

template <class Epi>
__device__ __forceinline__ void gemm_phase(LAS unsigned char* lds, const Gemm g, const StaticOrder& S, const Epi& E) {
    int tid_ = threadIdx.x; asm volatile("" : "+v"(tid_));
    const int tid = tid_, wid = __builtin_amdgcn_readfirstlane(tid >> 6), lane = tid & 63, wr = wid >> 2, wc = wid & 3, fr = lane & 15, fq = lane >> 4;
    const int K = g.K, nt = K / BK, lda = g.lda;
    unsigned voffA[2], voffB[2];
#pragma unroll
    for (int i = 0; i < 2; ++i) { int R, C; stage_rc(tid * 16 + i * 8192, R, C); const int Rb = Epi::PERM ? ((R & ~31) + perm32(R & 31)) : R;
        voffA[i] = (unsigned)(R * lda + C) * 2u; voffB[i] = (unsigned)(Rb * K + C) * 2u; }
    const size_t kstep = (size_t)(BK * 2);
    const size_t hstepA = (size_t)HALF * lda * 2, hstepB = (size_t)HALF * K * 2;
    const size_t tstepA = 2 * hstepA, tstepB = 2 * hstepB;
    const unsigned ldsw = (unsigned)wid * 1024u;
    const int aoff = lds_byte(wr * 64 + fr, fq * 8), boff = lds_byte(wc * 32 + fr, fq * 8);
#define PG8_SA(b, h) (((b) * 2 + (h)) * HTB)
#define PG8_SB(b, h) ((4 + (b) * 2 + (h)) * HTB)
#define PG8_STAGE(bufoff, gbase, voff) do { _Pragma("unroll") for (int _i = 0; _i < 2; ++_i) \
        __builtin_amdgcn_global_load_lds((const unsigned*)((const char*)(gbase) + (voff)[_i]), (LAS unsigned*)(lds + (bufoff) + ldsw + _i * 8192), 16, 0, 0); } while (0)
#define PG8_LDA(dst, b, h) do { _Pragma("unroll") for (int m = 0; m < 4; ++m) _Pragma("unroll") for (int k = 0; k < 2; ++k) dst[m][k] = *(const LAS bf16x8*)(lds + PG8_SA(b, h) + aoff + m * 2048 + k * 1024); } while (0)
#define PG8_LDB(dst, b, h) do { _Pragma("unroll") for (int n = 0; n < 2; ++n) _Pragma("unroll") for (int k = 0; k < 2; ++k) dst[n][k] = *(const LAS bf16x8*)(lds + PG8_SB(b, h) + boff + n * 2048 + k * 1024); } while (0)
#define PG8_MMA(ai, bj, At, Bt) do { __builtin_amdgcn_s_setprio(1); _Pragma("unroll") for (int m = 0; m < 4; ++m) _Pragma("unroll") for (int n = 0; n < 2; ++n) _Pragma("unroll") for (int k = 0; k < 2; ++k) \
        acc[ai][bj][m][n] = __builtin_amdgcn_mfma_f32_16x16x32_bf16(Bt[n][k], At[m][k], acc[ai][bj][m][n], 0, 0, 0); __builtin_amdgcn_s_setprio(0); } while (0)
#define PG8_WAIT_V(n) asm volatile("s_waitcnt vmcnt(" #n ")" ::: "memory")
#define PG8_WAIT_L(n) asm volatile("s_waitcnt lgkmcnt(" #n ")" ::: "memory")
#define PG8_BAR __builtin_amdgcn_s_barrier()
#define PG8_SCHED __builtin_amdgcn_sched_barrier(0)
    Unit cur, nxt; int ui = 0;
    if (!S.next(0, cur)) return;
    f32x4 acc[2][2][4][2];
#pragma unroll
    for (int a = 0; a < 2; ++a)
#pragma unroll
        for (int b = 0; b < 2; ++b)
#pragma unroll
            for (int m = 0; m < 4; ++m)
#pragma unroll
                for (int n = 0; n < 2; ++n) acc[a][b][m][n] = (f32x4){0.f, 0.f, 0.f, 0.f};
    bf16x8 At[4][2], B0[2][2], B1[2][2];
    const char* cA = (const char*)g.A + (size_t)cur.pm * tstepA; const char* cB = (const char*)g.Bt + (size_t)cur.pn * tstepB;
    PG8_STAGE(PG8_SB(0, 0), cB, voffB); PG8_STAGE(PG8_SB(0, 1), cB + hstepB, voffB); PG8_STAGE(PG8_SA(0, 0), cA, voffA); PG8_STAGE(PG8_SA(0, 1), cA + hstepA, voffA);
    if (wr == 1) PG8_BAR;
    PG8_WAIT_V(2); PG8_BAR;
    PG8_STAGE(PG8_SB(1, 0), cB + kstep, voffB); PG8_STAGE(PG8_SA(1, 0), cA + kstep, voffA); PG8_STAGE(PG8_SB(1, 1), cB + hstepB + kstep, voffB);
    PG8_WAIT_V(6); PG8_BAR;
    for (;;) {
        const bool has_next = S.next(ui + 1, nxt);
        const char* nA = has_next ? (const char*)g.A + (size_t)nxt.pm * tstepA : cA; const char* nB = has_next ? (const char*)g.Bt + (size_t)nxt.pn * tstepB : cB;
        for (int t = 0; t < nt; t += 2) {
            const bool last = (t == nt - 2);
            const char* a1 = cA + (size_t)(t + 1) * kstep;
            const char* a2 = last ? nA : cA + (size_t)(t + 2) * kstep; const char* b2 = last ? nB : cB + (size_t)(t + 2) * kstep;
            const char* a3 = a2 + kstep; const char* b3 = b2 + kstep;
            PG8_STAGE(PG8_SA(1, 1), a1 + hstepA, voffA); PG8_SCHED; PG8_LDB(B0, 0, 0); PG8_LDB(B1, 0, 1); PG8_SCHED; PG8_LDA(At, 0, 0);
            PG8_WAIT_V(8); PG8_WAIT_L(0); PG8_BAR; PG8_MMA(0, 0, At, B0); PG8_MMA(0, 1, At, B1); PG8_BAR; PG8_SCHED;
            PG8_STAGE(PG8_SB(0, 0), b2, voffB); PG8_STAGE(PG8_SB(0, 1), b2 + hstepB, voffB); PG8_STAGE(PG8_SA(0, 0), a2, voffA); PG8_SCHED; PG8_LDA(At, 0, 1);
            PG8_WAIT_V(8); PG8_WAIT_L(0); PG8_BAR; PG8_MMA(1, 0, At, B0); PG8_MMA(1, 1, At, B1); PG8_BAR; PG8_SCHED;
            PG8_STAGE(PG8_SA(0, 1), a2 + hstepA, voffA); PG8_SCHED; PG8_LDB(B0, 1, 0); PG8_LDB(B1, 1, 1); PG8_SCHED; PG8_LDA(At, 1, 0);
            PG8_WAIT_V(8); PG8_WAIT_L(0); PG8_BAR; PG8_MMA(0, 0, At, B0); PG8_MMA(0, 1, At, B1); PG8_BAR; PG8_SCHED;
            PG8_STAGE(PG8_SB(1, 0), b3, voffB); PG8_STAGE(PG8_SB(1, 1), b3 + hstepB, voffB); PG8_STAGE(PG8_SA(1, 0), a3, voffA); PG8_SCHED; PG8_LDA(At, 1, 1);
            PG8_WAIT_V(8); PG8_WAIT_L(0); PG8_BAR; PG8_MMA(1, 0, At, B0); PG8_MMA(1, 1, At, B1); PG8_BAR; PG8_SCHED;
        }
        if (wr == 0) PG8_BAR;
        E(acc, cur, wr, wc, fr, fq);
        if (!has_next) break;
#pragma unroll
        for (int a = 0; a < 2; ++a)
#pragma unroll
            for (int b = 0; b < 2; ++b)
#pragma unroll
                for (int m = 0; m < 4; ++m)
#pragma unroll
                    for (int n = 0; n < 2; ++n) acc[a][b][m][n] = (f32x4){0.f, 0.f, 0.f, 0.f};
        cur = nxt; cA = nA; cB = nB; ++ui;
        if (wr == 1) PG8_BAR;
    }
    PG8_WAIT_V(0);
    PG8_BAR;
#undef PG8_SA
#undef PG8_SB
#undef PG8_STAGE
#undef PG8_LDA
#undef PG8_LDB
#undef PG8_MMA
#undef PG8_WAIT_V
#undef PG8_WAIT_L
#undef PG8_BAR
#undef PG8_SCHED
}
}

struct Args {
    const float* x; const int* pos; const float* g_pre; const float* w_in; const float* conv_w; const float* conv_b;
    const float* w_rg_a; const float* b_rg_a; const float* w_rg_x; const float* b_rg_x; const float* lam; const float* sinks;
    const float* w_rnn; const float* w_attn; const float* w_out; const float* g_post; const float* g_mlp_pre;
    const float* w_up; const float* w_down; const float* g_mlp_post;
    float* out; unsigned char* ws;
};

__device__ __forceinline__ void p0_transpose_item(const float* W, int K, int N, bf16_t* WT, LAS float* scr, int item, int lane, float scale = 1.0f) {
    const int nblk = N / 32, kb = item / nblk, nb = item % nblk, k0 = 64 * kb, n0 = 32 * nb;
    float tv[32];
#pragma unroll
    for (int i = 0; i < 32; ++i) tv[i] = W[(size_t)(k0 + 2 * i + (lane >> 5)) * N + n0 + (lane & 31)];
#pragma unroll
    for (int i = 0; i < 32; ++i) scr[(2 * i + (lane >> 5)) * 33 + (lane & 31)] = tv[i] * scale;
    asm volatile("s_waitcnt lgkmcnt(0)" ::: "memory");
    const int c = lane & 7;
#pragma unroll
    for (int j = 0; j < 4; ++j) { const int n = (lane >> 3) + 8 * j; const LAS float* s = scr + (8 * c) * 33 + n;
        u32x4 o; o.x = cvt_pk_bf16(s[0 * 33], s[1 * 33]); o.y = cvt_pk_bf16(s[2 * 33], s[3 * 33]); o.z = cvt_pk_bf16(s[4 * 33], s[5 * 33]); o.w = cvt_pk_bf16(s[6 * 33], s[7 * 33]);
        *(u32x4*)(WT + (size_t)(n0 + n) * K + k0 + 8 * c) = o; }
    asm volatile("s_waitcnt lgkmcnt(0)" ::: "memory");
}

__device__ __forceinline__ void rms_row_to_bf16(const float* xrow, const float* g, bf16_t* orow, int lane) {
    const f32x4* xr = (const f32x4*)xrow + lane; const f32x4* gr = (const f32x4*)g + lane;
    f32x4 v[8]; float s = 0.f;
#pragma unroll
    for (int j = 0; j < 8; ++j) { v[j] = xr[64 * j]; s += (v[j].x * v[j].x + v[j].y * v[j].y) + (v[j].z * v[j].z + v[j].w * v[j].w); }
    const float rstd = 1.0f / sqrtf(wave_sum(s) * (1.f / D_MODEL) + RMS_EPS);
    u32x2* o8 = (u32x2*)orow + lane;
#pragma unroll
    for (int j = 0; j < 8; ++j) { const f32x4 gg = gr[64 * j]; u32x2 w; w.x = cvt_pk_bf16(v[j].x * rstd * gg.x, v[j].y * rstd * gg.y); w.y = cvt_pk_bf16(v[j].z * rstd * gg.z, v[j].w * rstd * gg.w); o8[64 * j] = w; }
}

constexpr int XC_LD = 264;
constexpr int XC_BYTES = 128 * XC_LD * 2;
__device__ __forceinline__ void rnn_tile(const Args& a, LAS unsigned char* lds, int tile, int nblk) {
    int tid_ = threadIdx.x; asm volatile("" : "+v"(tid_));
    const int tid = tid_, lane = tid & 63, w = __builtin_amdgcn_readfirstlane(tid >> 6), hi = lane >> 5, l32 = lane & 31;
    bf16_t* proj = (bf16_t*)(a.ws + WS_P);
    bf16_t* qbuf = (bf16_t*)a.out;
    LAS bf16_t* xc = (LAS bf16_t*)lds;
    LAS bf16_t* yg = (LAS bf16_t*)(lds + XC_BYTES);
    LAS unsigned* rmask = (LAS unsigned*)(lds + 2 * XC_BYTES);
    const int tok0 = tile * 128, sidx0 = (tile & 63) * 128;
#pragma unroll
    for (int i = 0; i < 8; ++i) { const int p = tid + 512 * i, row = p >> 5, c16 = p & 31;
        *(LAS u32x4*)(yg + row * XC_LD + c16 * 8) = *(const u32x4*)(proj + (size_t)(tok0 + row) * D_IN + OFF_YR + nblk * 256 + c16 * 8); }
    {
        const int cgp = tid & 31, ts = tid >> 5, ch = nblk * 256 + cgp * 8;
        float wk[4][8], bb[8];
#pragma unroll
        for (int k = 0; k < 4; ++k) { const f32x4 w0 = *(const f32x4*)(a.conv_w + k * D_RNN + ch), w1 = *(const f32x4*)(a.conv_w + k * D_RNN + ch + 4);
            wk[k][0] = w0.x; wk[k][1] = w0.y; wk[k][2] = w0.z; wk[k][3] = w0.w; wk[k][4] = w1.x; wk[k][5] = w1.y; wk[k][6] = w1.z; wk[k][7] = w1.w; }
        { const f32x4 b0 = *(const f32x4*)(a.conv_b + ch), b1 = *(const f32x4*)(a.conv_b + ch + 4); bb[0] = b0.x; bb[1] = b0.y; bb[2] = b0.z; bb[3] = b0.w; bb[4] = b1.x; bb[5] = b1.y; bb[6] = b1.z; bb[7] = b1.w; }
        u32x4 raw[11];
#pragma unroll
        for (int j = 0; j < 11; ++j) { const int tl = ts * 8 + j - 3;
            if (sidx0 + tl >= 0) raw[j] = *(const u32x4*)(proj + (size_t)(tok0 + tl) * D_IN + OFF_XR + ch); else raw[j] = (u32x4){0u, 0u, 0u, 0u}; }
#pragma unroll
        for (int j = 0; j < 8; ++j) { float y[8];
#pragma unroll
            for (int e = 0; e < 8; ++e) y[e] = bb[e];
#pragma unroll
            for (int k = 0; k < 4; ++k) { const u32x4 r = raw[j + k];
                y[0] += wk[k][0] * bflo(r.x); y[1] += wk[k][1] * bfhi(r.x); y[2] += wk[k][2] * bflo(r.y); y[3] += wk[k][3] * bfhi(r.y);
                y[4] += wk[k][4] * bflo(r.z); y[5] += wk[k][5] * bfhi(r.z); y[6] += wk[k][6] * bflo(r.w); y[7] += wk[k][7] * bfhi(r.w); }
            u32x4 o; o.x = cvt_pk_bf16(y[0], y[1]); o.y = cvt_pk_bf16(y[2], y[3]); o.z = cvt_pk_bf16(y[4], y[5]); o.w = cvt_pk_bf16(y[6], y[7]);
            *(LAS u32x4*)(xc + (ts * 8 + j) * XC_LD + cgp * 8) = o; }
        if (tid < 128) { const bool z = (a.pos[tok0 + tid] == 0); const unsigned long long bal = __ballot(z); if (lane == 0) { rmask[2 * w] = (unsigned)bal; rmask[2 * w + 1] = (unsigned)(bal >> 32); } }
    }
    __syncthreads();
    const int cl = w * 32 + l32, c = nblk * 256 + cl;
    const bf16_t* wa = (const bf16_t*)(a.ws + WS_WRGA) + ((size_t)((nblk * 8 + w) * 16) * 64 + lane) * 8;
    const bf16_t* wx = (const bf16_t*)(a.ws + WS_WRGX) + ((size_t)((nblk * 8 + w) * 16) * 64 + lane) * 8;
    const float bav = -LOG2E * a.b_rg_a[c], bxv = -LOG2E * a.b_rg_x[c];
    f32x16 ga[4], gx[4];
#pragma unroll
    for (int mb = 0; mb < 4; ++mb)
#pragma unroll
        for (int i = 0; i < 16; ++i) { ga[mb][i] = bav; gx[mb][i] = bxv; }
    bf16x8 fa[4], fx[4];
#pragma unroll
    for (int p = 0; p < 3; ++p) { fa[p] = *(const bf16x8*)(wa + 512 * p); fx[p] = *(const bf16x8*)(wx + 512 * p); }
#pragma unroll
    for (int kk = 0; kk < 16; ++kk) {
        if (kk + 3 < 16) { fa[(kk + 3) & 3] = *(const bf16x8*)(wa + 512 * (kk + 3)); fx[(kk + 3) & 3] = *(const bf16x8*)(wx + 512 * (kk + 3)); }
#pragma unroll
        for (int mb = 0; mb < 4; ++mb) {
            const bf16x8 af = *(const LAS bf16x8*)(xc + (32 * mb + l32) * XC_LD + 16 * kk + 8 * hi);
            ga[mb] = __builtin_amdgcn_mfma_f32_32x32x16_bf16(af, fa[kk & 3], ga[mb], 0, 0, 0);
            gx[mb] = __builtin_amdgcn_mfma_f32_32x32x16_bf16(af, fx[kk & 3], gx[mb], 0, 0, 0);
        }
    }
    const float nsp = -8.0f * LOG2E * log1pf(expf(-a.lam[c]));
    float H = 0.f, C = 1.f;
#pragma unroll
    for (int mb = 0; mb < 4; ++mb) {
        const unsigned mw = (unsigned)__builtin_amdgcn_readfirstlane((int)rmask[mb]);
        float av[16], bv[16];
#pragma unroll
        for (int i = 0; i < 16; ++i) {
            const int row = 8 * (i >> 2) + 4 * hi + (i & 3);
            const float r = __builtin_amdgcn_rcpf(1.0f + __builtin_amdgcn_exp2f(ga[mb][i])), ig = __builtin_amdgcn_rcpf(1.0f + __builtin_amdgcn_exp2f(gx[mb][i]));
            const float aa = __builtin_amdgcn_exp2f(nsp * r);
            const float mult = __builtin_amdgcn_sqrtf(fmaf(-aa, aa, 1.0f));
            const float xv = bf2f(xc[(32 * mb + row) * XC_LD + cl]);
            av[i] = aa; bv[i] = mult * ig * xv;
        }
        if (mw != 0u) {
#pragma unroll
            for (int i = 0; i < 16; ++i) { const int row = 8 * (i >> 2) + 4 * hi + (i & 3);
                if ((mw >> row) & 1u) { const float ig = __builtin_amdgcn_rcpf(1.0f + __builtin_amdgcn_exp2f(gx[mb][i])); av[i] = 0.f; bv[i] = ig * bf2f(xc[(32 * mb + row) * XC_LD + cl]); } }
        }
#pragma unroll
        for (int g = 0; g < 4; ++g) {
            const float As = (av[4 * g] * av[4 * g + 1]) * (av[4 * g + 2] * av[4 * g + 3]);
            const float Bs = ((bv[4 * g] * av[4 * g + 1] + bv[4 * g + 1]) * av[4 * g + 2] + bv[4 * g + 2]) * av[4 * g + 3] + bv[4 * g + 3];
            const float Ao = __shfl_xor(As, 32), Bo = __shfl_xor(Bs, 32);
            const float Alo = hi ? Ao : As, Blo = hi ? Bo : Bs, Ahi = hi ? As : Ao, Bhi = hi ? Bs : Bo;
            float hs = hi ? (H * Alo + Blo) : H, cs = hi ? (C * Alo) : C;
#pragma unroll
            for (int j = 0; j < 4; ++j) { hs = av[4 * g + j] * hs + bv[4 * g + j]; cs *= av[4 * g + j];
                const int li = (32 * mb + 8 * g + 4 * hi + j) * XC_LD + cl;
                const float gy = bf2f(yg[li]);
                xc[li] = (bf16_t)(cvt_pk_bf16(hs * gy, 0.f) & 0xffffu); yg[li] = (bf16_t)(cvt_pk_bf16(cs * gy, 0.f) & 0xffffu); }
            H = (H * Alo + Blo) * Ahi + Bhi; C *= Alo * Ahi;
        }
    }
    if (hi == 0) { ((float*)(a.ws + WS_SUMA))[(size_t)tile * D_RNN + c] = C; ((float*)(a.ws + WS_SUMB))[(size_t)tile * D_RNN + c] = H; }
    __syncthreads();
#pragma unroll
    for (int i = 0; i < 8; ++i) { const int p = tid + 512 * i, row = p >> 5, c16 = p & 31;
        *(u32x4*)(proj + (size_t)(tok0 + row) * D_IN + OFF_YR + nblk * 256 + c16 * 8) = *(const LAS u32x4*)(xc + row * XC_LD + c16 * 8);
        *(u32x4*)(qbuf + (size_t)(tok0 + row) * D_RNN + nblk * 256 + c16 * 8) = *(const LAS u32x4*)(yg + row * XC_LD + c16 * 8); }
    __syncthreads();
}
__device__ __forceinline__ void rnn_fixup(const Args& a, int bx, int G) {
    bf16_t* proj = (bf16_t*)(a.ws + WS_P); const bf16_t* qbuf = (const bf16_t*)a.out; const float* hin = (const float*)(a.ws + WS_HIN);
    int tid_ = threadIdx.x; asm volatile("" : "+v"(tid_));
    for (int idx = bx * 512 + tid_; idx < M_TOK * 256; idx += G * 512) {
        const int row = idx >> 8, c8 = (idx & 255) * 8, tile = row >> 7;
        bf16_t* pp = proj + (size_t)row * D_IN + OFF_YR + c8;
        const u32x4 p = *(const u32x4*)pp, q = *(const u32x4*)(qbuf + (size_t)row * D_RNN + c8);
        const f32x4 h0 = *(const f32x4*)(hin + (size_t)tile * D_RNN + c8), h1 = *(const f32x4*)(hin + (size_t)tile * D_RNN + c8 + 4);
        u32x4 o;
        o.x = cvt_pk_bf16(bflo(p.x) + bflo(q.x) * h0.x, bfhi(p.x) + bfhi(q.x) * h0.y); o.y = cvt_pk_bf16(bflo(p.y) + bflo(q.y) * h0.z, bfhi(p.y) + bfhi(q.y) * h0.w);
        o.z = cvt_pk_bf16(bflo(p.z) + bflo(q.z) * h1.x, bfhi(p.z) + bfhi(q.z) * h1.y); o.w = cvt_pk_bf16(bflo(p.w) + bflo(q.w) * h1.z, bfhi(p.w) + bfhi(q.w) * h1.w);
        *(u32x4*)pp = o;
    }
}

constexpr int KS_LD = 72, VT_LD = 264, VT_OFF = 256 * KS_LD * 2;
constexpr int TAB_LDB = 144, TC_OFF = VT_OFF + 64 * VT_LD * 2, TS_OFF = TC_OFF + 128 * TAB_LDB, ST_OFF = TS_OFF + 128 * TAB_LDB, ST_LDB = 144, ST_WAVE = 32 * ST_LDB;
static_assert(ST_OFF + 8 * ST_WAVE <= LDS_BYTES, "attention LDS map");
__device__ __forceinline__ void attn_item(const Args& a, LAS unsigned char* lds, int item) {
    int tid_ = threadIdx.x; asm volatile("" : "+v"(tid_));
    const int tid = tid_, lane = tid & 63, w = __builtin_amdgcn_readfirstlane(tid >> 6), hi = lane >> 5, l32 = lane & 31;
    const int b = item >> 8, nb = (item >> 2) & 63, hk = item & 3;
    bf16_t* proj = (bf16_t*)(a.ws + WS_P);
    const float* tcos = (const float*)(a.ws + WS_COS); const float* tsin = (const float*)(a.ws + WS_SIN);
    LAS bf16_t* Ks = (LAS bf16_t*)lds; LAS bf16_t* Vt = (LAS bf16_t*)(lds + VT_OFF);
    const int tok0 = b * SEQ + nb * 128;
    const int hq = hk * 8 + w;
    const float sink2 = a.sinks[hq] * LOG2E;
    const float CS = 0.125f * LOG2E;
    u32x4 qraw[4];
    LAS unsigned char* stage = lds + ST_OFF + w * ST_WAVE;
    const int st_rw = ((lane >> 3) * ST_LDB) + (lane & 7) * 16;
#define ATT_LOADQ(QQ) do { const bf16_t* qp_ = proj + (size_t)(tok0 + 32 * (QQ) + (lane >> 3)) * D_IN + OFF_Q + hq * 64 + 8 * (lane & 7); \
        _Pragma("unroll") for (int it = 0; it < 4; ++it) qraw[it] = *(const u32x4*)(qp_ + (size_t)(8 * it) * D_IN); } while (0)
    ATT_LOADQ(0);
    {
        const int key = tid >> 1, part = tid & 1;
        if (nb == 0 && key < 128) {
            const u32x4 z = (u32x4){0u, 0u, 0u, 0u};
            *(LAS u32x4*)(Ks + key * KS_LD + 16 * part) = z; *(LAS u32x4*)(Ks + key * KS_LD + 16 * part + 8) = z;
            *(LAS u32x4*)(Ks + key * KS_LD + 32 + 16 * part) = z; *(LAS u32x4*)(Ks + key * KS_LD + 32 + 16 * part + 8) = z;
#pragma unroll
            for (int e = 0; e < 32; ++e) Vt[(32 * part + e) * VT_LD + key] = 0;
        } else {
            const int tok = tok0 - 128 + key;
            const bf16_t* ksrc = proj + (size_t)tok * D_IN + OFF_K + hk * 64 + 16 * part;
            const u32x4 x1a = *(const u32x4*)(ksrc), x1b = *(const u32x4*)(ksrc + 8), x2a = *(const u32x4*)(ksrc + 32), x2b = *(const u32x4*)(ksrc + 40);
            float x1[16], x2[16], cs[16], sn[16];
            x1[0] = bflo(x1a.x); x1[1] = bfhi(x1a.x); x1[2] = bflo(x1a.y); x1[3] = bfhi(x1a.y); x1[4] = bflo(x1a.z); x1[5] = bfhi(x1a.z); x1[6] = bflo(x1a.w); x1[7] = bfhi(x1a.w);
            x1[8] = bflo(x1b.x); x1[9] = bfhi(x1b.x); x1[10] = bflo(x1b.y); x1[11] = bfhi(x1b.y); x1[12] = bflo(x1b.z); x1[13] = bfhi(x1b.z); x1[14] = bflo(x1b.w); x1[15] = bfhi(x1b.w);
            x2[0] = bflo(x2a.x); x2[1] = bfhi(x2a.x); x2[2] = bflo(x2a.y); x2[3] = bfhi(x2a.y); x2[4] = bflo(x2a.z); x2[5] = bfhi(x2a.z); x2[6] = bflo(x2a.w); x2[7] = bfhi(x2a.w);
            x2[8] = bflo(x2b.x); x2[9] = bfhi(x2b.x); x2[10] = bflo(x2b.y); x2[11] = bfhi(x2b.y); x2[12] = bflo(x2b.z); x2[13] = bfhi(x2b.z); x2[14] = bflo(x2b.w); x2[15] = bfhi(x2b.w);
#pragma unroll
            for (int q4 = 0; q4 < 4; ++q4) { const f32x4 cv = *(const f32x4*)(tcos + (size_t)tok * 32 + 16 * part + 4 * q4), sv = *(const f32x4*)(tsin + (size_t)tok * 32 + 16 * part + 4 * q4);
                cs[4 * q4] = cv.x; cs[4 * q4 + 1] = cv.y; cs[4 * q4 + 2] = cv.z; cs[4 * q4 + 3] = cv.w; sn[4 * q4] = sv.x; sn[4 * q4 + 1] = sv.y; sn[4 * q4 + 2] = sv.z; sn[4 * q4 + 3] = sv.w; }
            float o1[16], o2[16];
#pragma unroll
            for (int e = 0; e < 16; ++e) { o1[e] = x1[e] * cs[e] - x2[e] * sn[e]; o2[e] = x2[e] * cs[e] + x1[e] * sn[e]; }
            u32x4 wv;
            wv.x = cvt_pk_bf16(o1[0], o1[1]); wv.y = cvt_pk_bf16(o1[2], o1[3]); wv.z = cvt_pk_bf16(o1[4], o1[5]); wv.w = cvt_pk_bf16(o1[6], o1[7]); *(LAS u32x4*)(Ks + key * KS_LD + 16 * part) = wv;
            wv.x = cvt_pk_bf16(o1[8], o1[9]); wv.y = cvt_pk_bf16(o1[10], o1[11]); wv.z = cvt_pk_bf16(o1[12], o1[13]); wv.w = cvt_pk_bf16(o1[14], o1[15]); *(LAS u32x4*)(Ks + key * KS_LD + 16 * part + 8) = wv;
            wv.x = cvt_pk_bf16(o2[0], o2[1]); wv.y = cvt_pk_bf16(o2[2], o2[3]); wv.z = cvt_pk_bf16(o2[4], o2[5]); wv.w = cvt_pk_bf16(o2[6], o2[7]); *(LAS u32x4*)(Ks + key * KS_LD + 32 + 16 * part) = wv;
            wv.x = cvt_pk_bf16(o2[8], o2[9]); wv.y = cvt_pk_bf16(o2[10], o2[11]); wv.z = cvt_pk_bf16(o2[12], o2[13]); wv.w = cvt_pk_bf16(o2[14], o2[15]); *(LAS u32x4*)(Ks + key * KS_LD + 32 + 16 * part + 8) = wv;
            const bf16_t* vsrc = proj + (size_t)tok * D_IN + OFF_V + hk * 64 + 32 * part;
#pragma unroll
            for (int q4 = 0; q4 < 4; ++q4) { const u32x4 vv = *(const u32x4*)(vsrc + 8 * q4); LAS bf16_t* vd = Vt + (32 * part + 8 * q4) * VT_LD + key;
                vd[0 * VT_LD] = (bf16_t)(vv.x & 0xffffu); vd[1 * VT_LD] = (bf16_t)(vv.x >> 16); vd[2 * VT_LD] = (bf16_t)(vv.y & 0xffffu); vd[3 * VT_LD] = (bf16_t)(vv.y >> 16);
                vd[4 * VT_LD] = (bf16_t)(vv.z & 0xffffu); vd[5 * VT_LD] = (bf16_t)(vv.z >> 16); vd[6 * VT_LD] = (bf16_t)(vv.w & 0xffffu); vd[7 * VT_LD] = (bf16_t)(vv.w >> 16); }
        }
    }
#pragma unroll
    for (int i = 0; i < 2; ++i) { const int idx = tid + 512 * i, tk = idx >> 3, f4 = idx & 7;
        *(LAS f32x4*)(lds + TC_OFF + tk * TAB_LDB + f4 * 16) = *(const f32x4*)(tcos + (size_t)tok0 * 32 + idx * 4);
        *(LAS f32x4*)(lds + TS_OFF + tk * TAB_LDB + f4 * 16) = *(const f32x4*)(tsin + (size_t)tok0 * 32 + idx * 4); }
    __syncthreads();
#pragma unroll 1
    for (int qq = 0; qq < 4; ++qq) {
        bf16_t* obase = (bf16_t*)(a.ws + WS_H) + (size_t)(tok0 + 32 * qq + (lane >> 3)) * 2048 + hq * 64 + 8 * (lane & 7);
        bf16x8 qf[4];
#pragma unroll
        for (int it = 0; it < 4; ++it) *(LAS u32x4*)(stage + st_rw + it * 8 * ST_LDB) = qraw[it];
        u32x4 qfr[4]; f32x4 qc[4], qs[4];
#pragma unroll
        for (int dd = 0; dd < 4; ++dd) qfr[dd] = *(const LAS u32x4*)(stage + l32 * ST_LDB + (16 * dd + 8 * hi) * 2);
#pragma unroll
        for (int d2 = 0; d2 < 2; ++d2) { const int to = (32 * qq + l32) * TAB_LDB + (16 * d2 + 8 * hi) * 4;
            qc[2 * d2] = *(const LAS f32x4*)(lds + TC_OFF + to); qc[2 * d2 + 1] = *(const LAS f32x4*)(lds + TC_OFF + to + 16);
            qs[2 * d2] = *(const LAS f32x4*)(lds + TS_OFF + to); qs[2 * d2 + 1] = *(const LAS f32x4*)(lds + TS_OFF + to + 16); }
#pragma unroll
        for (int d2 = 0; d2 < 2; ++d2) {
            const f32x4 c0 = qc[2 * d2], c1 = qc[2 * d2 + 1], s0 = qs[2 * d2], s1 = qs[2 * d2 + 1];
            const float cs[8] = {c0.x, c0.y, c0.z, c0.w, c1.x, c1.y, c1.z, c1.w}, sn[8] = {s0.x, s0.y, s0.z, s0.w, s1.x, s1.y, s1.z, s1.w};
            const u32x4 r1 = qfr[d2], r2 = qfr[d2 + 2];
            const float x1[8] = {bflo(r1.x), bfhi(r1.x), bflo(r1.y), bfhi(r1.y), bflo(r1.z), bfhi(r1.z), bflo(r1.w), bfhi(r1.w)};
            const float x2[8] = {bflo(r2.x), bfhi(r2.x), bflo(r2.y), bfhi(r2.y), bflo(r2.z), bfhi(r2.z), bflo(r2.w), bfhi(r2.w)};
            float o1[8], o2[8];
#pragma unroll
            for (int e = 0; e < 8; ++e) { o1[e] = x1[e] * cs[e] - x2[e] * sn[e]; o2[e] = x2[e] * cs[e] + x1[e] * sn[e]; }
            u32x4 w1, w2;
            w1.x = cvt_pk_bf16(o1[0], o1[1]); w1.y = cvt_pk_bf16(o1[2], o1[3]); w1.z = cvt_pk_bf16(o1[4], o1[5]); w1.w = cvt_pk_bf16(o1[6], o1[7]);
            w2.x = cvt_pk_bf16(o2[0], o2[1]); w2.y = cvt_pk_bf16(o2[2], o2[3]); w2.z = cvt_pk_bf16(o2[4], o2[5]); w2.w = cvt_pk_bf16(o2[6], o2[7]);
            qf[d2] = __builtin_bit_cast(bf16x8, w1); qf[d2 + 2] = __builtin_bit_cast(bf16x8, w2);
        }
        if (qq < 3) ATT_LOADQ(qq + 1);
        f32x16 s[5];
#pragma unroll
        for (int kbi = 0; kbi < 5; ++kbi) {
#pragma unroll
            for (int i = 0; i < 16; ++i) s[kbi][i] = 0.f;
            const LAS bf16_t* kp = Ks + (32 * (qq + kbi) + l32) * KS_LD + 8 * hi;
#pragma unroll
            for (int dd = 0; dd < 4; ++dd) { const bf16x8 kf = *(const LAS bf16x8*)(kp + 16 * dd); s[kbi] = __builtin_amdgcn_mfma_f32_32x32x16_bf16(kf, qf[dd], s[kbi], 0, 0, 0); }
        }
        if (nb == 0) {
#pragma unroll
            for (int kbi = 0; kbi < 4; ++kbi) if (qq + kbi < 4) {
#pragma unroll
                for (int i = 0; i < 16; ++i) s[kbi][i] = -1e30f; }
        }
        const int tq = l32 - 4 * hi;
#pragma unroll
        for (int i = 0; i < 16; ++i) { const int rr = 8 * (i >> 2) + (i & 3); s[0][i] = (rr > tq) ? s[0][i] : -1e30f; s[4][i] = (rr <= tq) ? s[4][i] : -1e30f; }
        float mx = -1e30f;
#pragma unroll
        for (int kbi = 0; kbi < 5; ++kbi)
#pragma unroll
            for (int i = 0; i < 16; i += 2) mx = fmaxf(mx, fmaxf(s[kbi][i], s[kbi][i + 1]));
        mx = fmaxf(mx, __shfl_xor(mx, 32)); mx = fmaxf(mx * CS, sink2);
        const float nmx = -mx;
        float lsum = 0.f;
        bf16x8 pk[5][2];
#pragma unroll
        for (int kbi = 0; kbi < 5; ++kbi) {
#pragma unroll
            for (int i = 0; i < 16; ++i) { const float p = __builtin_amdgcn_exp2f(fmaf(s[kbi][i], CS, nmx)); s[kbi][i] = p; lsum += p; }
#pragma unroll
            for (int j2 = 0; j2 < 2; ++j2) { u32x4 pw;
                pw.x = cvt_pk_bf16(s[kbi][8 * j2 + 0], s[kbi][8 * j2 + 1]); pw.y = cvt_pk_bf16(s[kbi][8 * j2 + 2], s[kbi][8 * j2 + 3]);
                pw.z = cvt_pk_bf16(s[kbi][8 * j2 + 4], s[kbi][8 * j2 + 5]); pw.w = cvt_pk_bf16(s[kbi][8 * j2 + 6], s[kbi][8 * j2 + 7]);
                pk[kbi][j2] = __builtin_bit_cast(bf16x8, pw); }
        }
        lsum += __shfl_xor(lsum, 32); lsum += __builtin_amdgcn_exp2f(sink2 - mx);
        const float inv = 1.0f / lsum;
        f32x16 o[2];
#pragma unroll
        for (int db = 0; db < 2; ++db)
#pragma unroll
            for (int i = 0; i < 16; ++i) o[db][i] = 0.f;
#pragma unroll
        for (int kbi = 0; kbi < 5; ++kbi)
#pragma unroll
            for (int j2 = 0; j2 < 2; ++j2)
#pragma unroll
                for (int db = 0; db < 2; ++db) {
                    const LAS bf16_t* vp = Vt + (32 * db + l32) * VT_LD + 32 * (qq + kbi) + 16 * j2 + 4 * hi;
                    const s16x4 lo = *(const LAS s16x4*)vp, hh = *(const LAS s16x4*)(vp + 8);
                    const bf16x8 vf = (bf16x8){lo[0], lo[1], lo[2], lo[3], hh[0], hh[1], hh[2], hh[3]};
                    o[db] = __builtin_amdgcn_mfma_f32_32x32x16_bf16(vf, pk[kbi][j2], o[db], 0, 0, 0);
                }
#pragma unroll
        for (int db = 0; db < 2; ++db)
#pragma unroll
            for (int g = 0; g < 4; ++g) { u32x2 wv; wv.x = cvt_pk_bf16(o[db][4 * g] * inv, o[db][4 * g + 1] * inv); wv.y = cvt_pk_bf16(o[db][4 * g + 2] * inv, o[db][4 * g + 3] * inv);
                *(LAS u32x2*)(stage + l32 * ST_LDB + (32 * db + 8 * g + 4 * hi) * 2) = wv; }
#pragma unroll
        for (int it = 0; it < 4; ++it) { const u32x4 ov = *(const LAS u32x4*)(stage + st_rw + it * 8 * ST_LDB); *(u32x4*)(obase + (size_t)(8 * it) * 2048) = ov; }
    }
    __syncthreads();
#undef ATT_LOADQ
}

#define XB_TMO      128
#define XB_XCNT(j)  (256  + 64 * (j))
#define XB_XSUB(j)  (1280 + 64 * (j))
#define XB_XGEN(j)  (2304 + 64 * (j))
#define XB_TOP      3328
#define XB_TOPGEN   3392
#define XCD_BAR_WORDS 3456
#define XB_SPIN_CAP (1u << 18)

__device__ __forceinline__ unsigned xb_ld(unsigned* p)              { return __hip_atomic_load(p, __ATOMIC_RELAXED, __HIP_MEMORY_SCOPE_AGENT); }
__device__ __forceinline__ unsigned xb_add(unsigned* p, unsigned v) { return __hip_atomic_fetch_add(p, v, __ATOMIC_RELAXED, __HIP_MEMORY_SCOPE_AGENT); }
__device__ __forceinline__ unsigned xb_xcc_id() { return (unsigned)__builtin_amdgcn_s_getreg((3 << 11) | 20) & 0xFu; }
#define XB_SPIN(cond, bar) do { unsigned _sp = 0; while (cond) { __builtin_amdgcn_s_sleep(1); \
    if ((++_sp & 255u) == 0u) { if (xb_ld(&(bar)[XB_TMO])) break; if (_sp > XB_SPIN_CAP) { atomicAdd(&(bar)[XB_TMO], 1u); break; } } } } while (0)

struct XcdBarrier {
    unsigned* bar; unsigned x;
    volatile LAS unsigned* st;
};

__device__ __forceinline__ XcdBarrier xcd_barrier_post(unsigned* bar, volatile LAS unsigned* st) {
    XcdBarrier b; b.bar = bar; b.x = xb_xcc_id(); b.st = st;
    if (threadIdx.x == 0) (void)xb_add(&bar[XB_XCNT(b.x)], 1u);
    return b;
}
__device__ __forceinline__ void xcd_barrier_complete(unsigned* bar, unsigned x, unsigned& nloc, unsigned& nx) {
    const unsigned G = gridDim.x * gridDim.y * gridDim.z;
    unsigned sum, cnt, mine, sp = 0u;
    for (;;) {
        sum = 0u; cnt = 0u; mine = 0u;
#pragma unroll
        for (unsigned j = 0; j < 16; ++j) { const unsigned c = xb_ld(&bar[XB_XCNT(j)]); sum += c; cnt += (c > 0u) ? 1u : 0u; mine = (j == x) ? c : mine; }
        if (sum == G) break;
        __builtin_amdgcn_s_sleep(1);
        if ((++sp & 255u) == 0u) { if (xb_ld(&bar[XB_TMO])) break; if (sp > XB_SPIN_CAP) { atomicAdd(&bar[XB_TMO], 1u); break; } }
    }
    nloc = mine > 0u ? mine : 1u; nx = cnt > 0u ? cnt : 1u;
}

__device__ __forceinline__ void xcd_barrier(const XcdBarrier& b) {
    asm volatile("s_waitcnt vmcnt(0)" ::: "memory");
    __syncthreads();
    if (threadIdx.x == 0) {
        unsigned* bar = b.bar;
        __builtin_amdgcn_s_waitcnt(0);
        unsigned nloc = b.st[0], nx = b.st[1];
        if (nloc == 0u) { xcd_barrier_complete(bar, b.x, nloc, nx); b.st[0] = nloc; b.st[1] = nx; }
        const unsigned old = xb_add(&bar[XB_XSUB(b.x)], 1u);
        const unsigned gen = old / nloc;
        if (old + 1u == (gen + 1u) * nloc) {
            __builtin_amdgcn_fence(__ATOMIC_RELEASE, "agent");
            asm volatile("s_waitcnt vmcnt(0)" ::: "memory");
            const unsigned og = xb_add(&bar[XB_TOP], 1u);
            const unsigned tg = og / nx;
            if (og + 1u == (tg + 1u) * nx) xb_add(&bar[XB_TOPGEN], 1u);
            else XB_SPIN(xb_ld(&bar[XB_TOPGEN]) == tg, bar);
            __builtin_amdgcn_fence(__ATOMIC_ACQUIRE, "agent");
            xb_add(&bar[XB_XGEN(b.x)], 1u);
            asm volatile("s_waitcnt vmcnt(0)" ::: "memory");
        } else {
            XB_SPIN(xb_ld(&bar[XB_XGEN(b.x)]) == gen, bar);
            __builtin_amdgcn_fence(__ATOMIC_ACQUIRE, "agent");
            asm volatile("s_waitcnt vmcnt(0)" ::: "memory");
        }
    }
    __syncthreads();
}


__device__ __forceinline__ void grid_barrier(unsigned* ctr, unsigned target) {
    asm volatile("s_waitcnt vmcnt(0) lgkmcnt(0)" ::: "memory");
    __syncthreads();
    if (threadIdx.x == 0) {
        __builtin_amdgcn_fence(__ATOMIC_RELEASE, "agent");
        asm volatile("s_waitcnt vmcnt(0)" ::: "memory");
        __hip_atomic_fetch_add(ctr, 1u, __ATOMIC_RELAXED, __HIP_MEMORY_SCOPE_AGENT);
        while (__hip_atomic_load(ctr, __ATOMIC_RELAXED, __HIP_MEMORY_SCOPE_AGENT) < target) __builtin_amdgcn_s_sleep(2);
        __builtin_amdgcn_fence(__ATOMIC_ACQUIRE, "agent");
        asm volatile("s_waitcnt vmcnt(0)" ::: "memory");
    }
    __syncthreads();
}
#define GRID_SYNC_CG() do { asm volatile("s_waitcnt vmcnt(0) lgkmcnt(0)" ::: "memory"); grid.sync(); __builtin_amdgcn_fence(__ATOMIC_ACQUIRE, "agent"); asm volatile("s_waitcnt vmcnt(0)" ::: "memory"); } while (0)
#define GRID_SYNC() xcd_barrier(xbar)
__global__ void __launch_bounds__(512, 2) fwd_megakernel(Args a) {
    extern __shared__ __attribute__((aligned(16))) unsigned char lds_raw[];
    LAS unsigned char* lds = (LAS unsigned char*)lds_raw;
    cg::grid_group grid = cg::this_grid();
    const int tid = threadIdx.x, lane = tid & 63, wave = __builtin_amdgcn_readfirstlane(tid >> 6);
    const int G = gridDim.x, bx = blockIdx.x;
    const int gw = bx * 8 + wave, NGW = G * 8;
    bf16_t* proj = (bf16_t*)(a.ws + WS_P);
    bf16_t* Hb = (bf16_t*)(a.ws + WS_H);
    volatile LAS unsigned* xst = (volatile LAS unsigned*)(lds + LDS_BYTES - 16);
    if (tid == 0) { xst[0] = 0u; xst[1] = 0u; }
    __syncthreads();
    const XcdBarrier xbar = xcd_barrier_post((unsigned*)(a.ws + WS_CTL), xst);
    if (a.ws == nullptr) GRID_SYNC_CG();

    for (int rep_ = 0; rep_ < REP_A; ++rep_) {
    {
        LAS float* scr = (LAS float*)(lds + wave * 16384);
        constexpr int I_IN = (D_MODEL / 64) * (D_IN / 32), I_SQ = (2048 / 64) * (2048 / 32), I_UP = (D_MODEL / 64) * (D_FF / 32), I_DN = (D_FF / 64) * (D_MODEL / 32);
        constexpr int NITEMS = I_IN + 3 * I_SQ + I_UP + I_DN;
        for (int it = gw; it < NITEMS; it += NGW) {
            int r = it;
            if (r < I_IN) { p0_transpose_item(a.w_in, D_MODEL, D_IN, (bf16_t*)(a.ws + WS_WIN), scr, r, lane); continue; } r -= I_IN;
            if (r < I_SQ) { p0_transpose_item(a.w_rnn, 2048, 2048, (bf16_t*)(a.ws + WS_WRNN), scr, r, lane); continue; } r -= I_SQ;
            if (r < I_SQ) { p0_transpose_item(a.w_attn, 2048, 2048, (bf16_t*)(a.ws + WS_WATT), scr, r, lane); continue; } r -= I_SQ;
            if (r < I_SQ) { p0_transpose_item(a.w_out, 2048, 2048, (bf16_t*)(a.ws + WS_WOUT), scr, r, lane); continue; } r -= I_SQ;
            if (r < I_UP) { p0_transpose_item(a.w_up, D_MODEL, D_FF, (bf16_t*)(a.ws + WS_WUP), scr, r, lane); continue; } r -= I_UP;
            p0_transpose_item(a.w_down, D_FF, D_MODEL, (bf16_t*)(a.ws + WS_WDN), scr, r, lane);
        }
        for (int v = bx * 512 + tid; v < 2 * 65536; v += G * 512) {
            const int gate = v >> 16, r = v & 65535, ln = r & 63, kk = (r >> 6) & 15, wv = (r >> 10) & 7, nb = r >> 13;
            const float* src = (gate ? a.w_rg_x : a.w_rg_a) + (size_t)nb * 65536 + (size_t)(16 * kk + 8 * (ln >> 5)) * 256 + 32 * wv + (ln & 31);
            float e[8];
#pragma unroll
            for (int q = 0; q < 8; ++q) e[q] = src[q * 256] * (-LOG2E);
            u32x4 o; o.x = cvt_pk_bf16(e[0], e[1]); o.y = cvt_pk_bf16(e[2], e[3]); o.z = cvt_pk_bf16(e[4], e[5]); o.w = cvt_pk_bf16(e[6], e[7]);
            *(u32x4*)((bf16_t*)(a.ws + (gate ? WS_WRGX : WS_WRGA)) + (size_t)r * 8) = o;
        }
        for (int m = gw; m < M_TOK; m += NGW) rms_row_to_bf16(a.x + (size_t)m * D_MODEL, a.g_pre, Hb + (size_t)m * D_MODEL, lane);
        float* tcos = (float*)(a.ws + WS_COS); float* tsin = (float*)(a.ws + WS_SIN);
        for (int i = bx * 512 + tid; i < M_TOK * 32; i += G * 512) {
            const int tok = i >> 5, f = i & 31;
            const float inv_freq = exp2f(-(float)f * (13.287712379549449f / 32.0f));
            const float ang = (float)a.pos[tok] * inv_freq;
            float sv, cv; sincosf(ang, &sv, &cv); tcos[i] = cv; tsin[i] = sv;
        }
    }
    GRID_SYNC();
    }
    for (int rep_ = 0; rep_ < REP_G; ++rep_) {
    {
        pg8::Gemm g{Hb, (const bf16_t*)(a.ws + WS_WIN), M_TOK, D_IN, D_MODEL, D_MODEL}; pg8::StaticOrder S; S.init(M_TOK, D_IN, G, bx);
        pg8::EpiBf16 E{proj, D_IN, 0};
        pg8::gemm_phase<pg8::EpiBf16>(lds, g, S, E);
    }
    GRID_SYNC();
    }
    for (int rep_ = 0; rep_ < REP_B; ++rep_) {
    for (int it = bx; it < 256 * 8; it += G) rnn_tile(a, lds, it >> 3, it & 7);
    GRID_SYNC();
    }
    for (int rep_ = 0; rep_ < REP_C; ++rep_) {
    {
        if (tid < 32) {
            const int gi = bx * 32 + tid;
            if (gi < BATCH * D_RNN) {
                const int b = gi / D_RNN, ch = gi % D_RNN;
                const float* sa = (const float*)(a.ws + WS_SUMA) + (size_t)b * 64 * D_RNN + ch; const float* sb = (const float*)(a.ws + WS_SUMB) + (size_t)b * 64 * D_RNN + ch;
                float* hin = (float*)(a.ws + WS_HIN) + (size_t)b * 64 * D_RNN + ch;
                float H = 0.f;
                for (int j0 = 0; j0 < 64; j0 += 8) {
                    float av[8], bv[8];
#pragma unroll
                    for (int j = 0; j < 8; ++j) { av[j] = sa[(size_t)(j0 + j) * D_RNN]; bv[j] = sb[(size_t)(j0 + j) * D_RNN]; }
#pragma unroll
                    for (int j = 0; j < 8; ++j) { hin[(size_t)(j0 + j) * D_RNN] = H; H = H * av[j] + bv[j]; }
                }
            }
        }
        for (int it = bx; it < 1024; it += G) attn_item(a, lds, it);
    }
    GRID_SYNC();
    }
    rnn_fixup(a, bx, G);
    GRID_SYNC();
    {
        pg8::StaticOrder S; S.init(M_TOK, D_MODEL, G, bx);
        { pg8::Gemm g{proj + OFF_YR, (const bf16_t*)(a.ws + WS_WRNN), M_TOK, D_MODEL, D_RNN, D_IN};
          pg8::EpiGate E{proj + OFF_GR, nullptr, D_IN}; pg8::gemm_phase<pg8::EpiGate>(lds, g, S, E); }
        { pg8::Gemm g{Hb, (const bf16_t*)(a.ws + WS_WATT), M_TOK, D_MODEL, 2048, 2048};
          pg8::EpiGate E{proj + OFF_GA, proj + OFF_GR, D_IN}; pg8::gemm_phase<pg8::EpiGate>(lds, g, S, E); }
    }
    GRID_SYNC();
    for (int rep_ = 0; rep_ < REP_G; ++rep_) {
    {
        pg8::Gemm g{proj + OFF_GA, (const bf16_t*)(a.ws + WS_WOUT), M_TOK, D_MODEL, D_MODEL, D_IN}; pg8::StaticOrder S; S.init(M_TOK, D_MODEL, G, bx);
        pg8::EpiBf16 E{Hb, D_MODEL, 4}; pg8::gemm_phase<pg8::EpiBf16>(lds, g, S, E);
    }
    GRID_SYNC();
    }
    {
        const f32x4* g1 = (const f32x4*)a.g_post + lane; const f32x4* g2 = (const f32x4*)a.g_mlp_pre + lane;
        u32x2 nt[8]; f32x4 nx[8];
        int m = gw;
        if (m < M_TOK) {
#pragma unroll
            for (int j = 0; j < 8; ++j) { nt[j] = ((const u32x2*)(Hb + (size_t)m * D_MODEL) + lane)[64 * j]; nx[j] = ((const f32x4*)(a.x + (size_t)m * D_MODEL) + lane)[64 * j]; }
        }
        while (m < M_TOK) {
            f32x4 v[8], xx[8]; float s = 0.f;
#pragma unroll
            for (int j = 0; j < 8; ++j) { const u32x2 t2 = nt[j]; v[j] = (f32x4){bflo(t2.x), bfhi(t2.x), bflo(t2.y), bfhi(t2.y)}; xx[j] = nx[j]; s += (v[j].x * v[j].x + v[j].y * v[j].y) + (v[j].z * v[j].z + v[j].w * v[j].w); }
            const int mn = m + NGW;
            if (mn < M_TOK) {
#pragma unroll
                for (int j = 0; j < 8; ++j) { nt[j] = ((const u32x2*)(Hb + (size_t)mn * D_MODEL) + lane)[64 * j]; nx[j] = ((const f32x4*)(a.x + (size_t)mn * D_MODEL) + lane)[64 * j]; }
            }
            u32x2* x1w = (u32x2*)((bf16_t*)(a.ws + WS_X1) + (size_t)m * D_MODEL) + lane;
            const float rstd = 1.0f / sqrtf(wave_sum(s) * (1.f / D_MODEL) + RMS_EPS);
            float s2 = 0.f;
#pragma unroll
            for (int j = 0; j < 8; ++j) { const f32x4 gg = g1[64 * j]; v[j] = xx[j] + v[j] * rstd * gg;
                u32x2 w1; w1.x = cvt_pk_bf16(v[j].x, v[j].y); w1.y = cvt_pk_bf16(v[j].z, v[j].w); x1w[64 * j] = w1;
                s2 += (v[j].x * v[j].x + v[j].y * v[j].y) + (v[j].z * v[j].z + v[j].w * v[j].w); }
            const float rstd2 = 1.0f / sqrtf(wave_sum(s2) * (1.f / D_MODEL) + RMS_EPS);
            u32x2* o8 = (u32x2*)(Hb + (size_t)m * D_MODEL) + lane;
#pragma unroll
            for (int j = 0; j < 8; ++j) { const f32x4 gg = g2[64 * j]; u32x2 w; w.x = cvt_pk_bf16(v[j].x * rstd2 * gg.x, v[j].y * rstd2 * gg.y); w.y = cvt_pk_bf16(v[j].z * rstd2 * gg.z, v[j].w * rstd2 * gg.w); o8[64 * j] = w; }
            m = mn;
        }
    }
    GRID_SYNC();
    for (int rep_ = 0; rep_ < REP_G; ++rep_) {
    {
        pg8::Gemm g{Hb, (const bf16_t*)(a.ws + WS_WUP), M_TOK, D_FF, D_MODEL, D_MODEL}; pg8::StaticOrder S; S.init(M_TOK, D_FF, G, bx);
        pg8::EpiBf16 E{(bf16_t*)(a.ws + WS_U), D_FF, 3}; pg8::gemm_phase<pg8::EpiBf16>(lds, g, S, E);
    }
    GRID_SYNC();
    }
    for (int rep_ = 0; rep_ < REP_G; ++rep_) {
    {
        pg8::Gemm g{(const bf16_t*)(a.ws + WS_U), (const bf16_t*)(a.ws + WS_WDN), M_TOK, D_MODEL, D_FF, D_FF}; pg8::StaticOrder S; S.init(M_TOK, D_MODEL, G, bx);
        pg8::EpiBf16 E{(bf16_t*)(a.ws + WS_D), D_MODEL, 4}; pg8::gemm_phase<pg8::EpiBf16>(lds, g, S, E);
    }
    GRID_SYNC();
    }
    {
        const f32x4* g1 = (const f32x4*)a.g_mlp_post + lane;
        u32x2 nd[8], nx1[8];
        int m = gw;
        if (m < M_TOK) {
#pragma unroll
            for (int j = 0; j < 8; ++j) { nd[j] = ((const u32x2*)((const bf16_t*)(a.ws + WS_D) + (size_t)m * D_MODEL) + lane)[64 * j]; nx1[j] = ((const u32x2*)((const bf16_t*)(a.ws + WS_X1) + (size_t)m * D_MODEL) + lane)[64 * j]; }
        }
        while (m < M_TOK) {
            f32x4 v[8], x1[8]; float s = 0.f;
#pragma unroll
            for (int j = 0; j < 8; ++j) { const u32x2 t2 = nd[j], x2 = nx1[j]; v[j] = (f32x4){bflo(t2.x), bfhi(t2.x), bflo(t2.y), bfhi(t2.y)}; x1[j] = (f32x4){bflo(x2.x), bfhi(x2.x), bflo(x2.y), bfhi(x2.y)};
                s += (v[j].x * v[j].x + v[j].y * v[j].y) + (v[j].z * v[j].z + v[j].w * v[j].w); }
            const int mn = m + NGW;
            if (mn < M_TOK) {
#pragma unroll
                for (int j = 0; j < 8; ++j) { nd[j] = ((const u32x2*)((const bf16_t*)(a.ws + WS_D) + (size_t)mn * D_MODEL) + lane)[64 * j]; nx1[j] = ((const u32x2*)((const bf16_t*)(a.ws + WS_X1) + (size_t)mn * D_MODEL) + lane)[64 * j]; }
            }
            f32x4* orow = (f32x4*)(a.out + (size_t)m * D_MODEL) + lane;
            const float rstd = 1.0f / sqrtf(wave_sum(s) * (1.f / D_MODEL) + RMS_EPS);
#pragma unroll
            for (int j = 0; j < 8; ++j) { const f32x4 gg = g1[64 * j]; orow[64 * j] = x1[j] + v[j] * rstd * gg; }
            m = mn;
        }
    }
}

extern "C" void kernel_launch(void* const* d_in, const int* in_sizes, int n_in, void* d_out, int out_size, void* d_ws, size_t ws_size, hipStream_t stream) {
    static int grid_blocks = 0;
    if (grid_blocks == 0) {
        if (n_in != 20 || in_sizes[0] != M_TOK * D_MODEL || out_size != M_TOK * D_MODEL || ws_size < WS_END) {
            fprintf(stderr, "kernel_launch: unexpected shapes: n_in %d in0 %d out %d ws %zu (need %zu)\n", n_in, n_in > 0 ? in_sizes[0] : -1, out_size, ws_size, (size_t)WS_END); grid_blocks = -1; return; }
        int dev = 0, cus = 0, per_cu = 0;
        (void)hipGetDevice(&dev);
        (void)hipDeviceGetAttribute(&cus, hipDeviceAttributeMultiprocessorCount, dev);
        if (hipFuncSetAttribute((const void*)fwd_megakernel, hipFuncAttributeMaxDynamicSharedMemorySize, LDS_BYTES) != hipSuccess) fprintf(stderr, "kernel_launch: hipFuncSetAttribute failed\n");
        if (hipOccupancyMaxActiveBlocksPerMultiprocessor(&per_cu, (const void*)fwd_megakernel, 512, LDS_BYTES) != hipSuccess || per_cu < 1) { fprintf(stderr, "kernel_launch: occupancy query gave %d\n", per_cu); per_cu = 1; }
        (void)hipGetLastError();
        grid_blocks = cus * per_cu;
    }
    if (grid_blocks < 0) return;
    Args a{};
    a.x = (const float*)d_in[0]; a.pos = (const int*)d_in[1]; a.g_pre = (const float*)d_in[2]; a.w_in = (const float*)d_in[3]; a.conv_w = (const float*)d_in[4]; a.conv_b = (const float*)d_in[5];
    a.w_rg_a = (const float*)d_in[6]; a.b_rg_a = (const float*)d_in[7]; a.w_rg_x = (const float*)d_in[8]; a.b_rg_x = (const float*)d_in[9]; a.lam = (const float*)d_in[10]; a.sinks = (const float*)d_in[11];
    a.w_rnn = (const float*)d_in[12]; a.w_attn = (const float*)d_in[13]; a.w_out = (const float*)d_in[14]; a.g_post = (const float*)d_in[15]; a.g_mlp_pre = (const float*)d_in[16];
    a.w_up = (const float*)d_in[17]; a.w_down = (const float*)d_in[18]; a.g_mlp_post = (const float*)d_in[19];
    a.out = (float*)d_out; a.ws = (unsigned char*)d_ws;
    if (hipMemsetAsync((char*)d_ws + WS_CTL, 0, 16384, stream) != hipSuccess) { fprintf(stderr, "kernel_launch: memset failed\n"); return; }
    void* args[] = {&a};
    hipError_t e = hipLaunchCooperativeKernel((const void*)fwd_megakernel, dim3(grid_blocks), dim3(512), args, LDS_BYTES, stream);
    if (e != hipSuccess) fprintf(stderr, "cooperative launch failed: %s (grid %d)\n", hipGetErrorString(e), grid_blocks);
}
```
